# Optimizing an MI355X kernel written in HIP

```python
import math
import jax, jax.numpy as jnp
from jax import lax
import numpy as np

D_MODEL = 1024
BATCH = 32
SEQ = 2048
DEPTH = 4

N_MEM = 256
N_MIXERS = 2
N_A = (DEPTH + 1) // 2
N_B = DEPTH // 2
MIX_WIDTH = D_MODEL
MEM_HEADS = 4
MEM_HEAD_DIM = MIX_WIDTH // 4 // MEM_HEADS
MEM_WIDTH = MEM_HEADS * MEM_HEAD_DIM
MIXER_WIDTH = MIX_WIDTH - MEM_WIDTH

GLA_HEADS = 4
GLA_DV = MIXER_WIDTH // GLA_HEADS
GLA_DK = GLA_DV // 2
GLA_HK = GLA_HEADS * GLA_DK
GLA_GATE_RANK = 16
GLA_GATE_TAU = 16.0
GLA_CHUNK = 64
GLA_IN = 2 * GLA_HK + MIXER_WIDTH + GLA_GATE_RANK + MEM_WIDTH + MIX_WIDTH

DIL_GROUPS = ((128, 1), (512, 4), (2048, 16))
DIL_HEADS = 6
DIL_HEAD_DIM = MIXER_WIDTH // DIL_HEADS
DIL_IN = len(DIL_GROUPS) * 3 * MIXER_WIDTH + MEM_WIDTH + MIX_WIDTH

ROPE_THETA = 500000.0
ROPE_DIM = DIL_HEAD_DIM // 4
NORM_EPS = 1e-6

kernel_name = "hybrid_gla_dilated_memxattn"


def rmsnorm(x, w):
    xf = x.astype(jnp.float32)
    y = xf * lax.rsqrt(jnp.mean(xf * xf, axis=-1, keepdims=True) + NORM_EPS)
    return (y * w.astype(jnp.float32)).astype(x.dtype)


def partial_rope(x, pos):
    half = ROPE_DIM // 2
    inv = ROPE_THETA ** (-jnp.arange(half, dtype=jnp.float32) / half)
    ang = pos.astype(jnp.float32)[:, None] * inv[None, :]
    cos = jnp.cos(ang)[None, :, None, :]
    sin = jnp.sin(ang)[None, :, None, :]
    xr = x[..., :ROPE_DIM].astype(jnp.float32)
    x1, x2 = xr[..., :half], xr[..., half:]
    rot = jnp.concatenate([x1 * cos - x2 * sin, x1 * sin + x2 * cos], axis=-1).astype(x.dtype)
    return jnp.concatenate([rot, x[..., ROPE_DIM:]], axis=-1)


def memory_attention(q, mem_n, w_memkv):
    B, T, _ = q.shape
    kv = mem_n @ w_memkv
    k, v = jnp.split(kv, 2, axis=-1)
    q = q.reshape(B, T, MEM_HEADS, MEM_HEAD_DIM)
    k = k.reshape(B, N_MEM, MEM_HEADS, MEM_HEAD_DIM)
    v = v.reshape(B, N_MEM, MEM_HEADS, MEM_HEAD_DIM)
    s = jnp.einsum('bthd,bnhd->bhtn', q, k).astype(jnp.float32) * (MEM_HEAD_DIM ** -0.5)
    p = jax.nn.softmax(s, axis=-1).astype(v.dtype)
    o = jnp.einsum('bhtn,bnhd->bthd', p, v)
    return o.reshape(B, T, MEM_WIDTH)


def gla_chunked(q, k, v, log_a):
    B, T, H, Dk = q.shape
    Dv = v.shape[-1]
    C = GLA_CHUNK
    N = T // C
    f32 = jnp.float32
    q = (q.astype(f32) * (Dk ** -0.5)).reshape(B, N, C, H, Dk)
    k = k.astype(f32).reshape(B, N, C, H, Dk)
    v = v.astype(f32).reshape(B, N, C, H, Dv)
    b = jnp.cumsum(log_a.astype(f32).reshape(B, N, C, H, Dk), axis=2)
    b_last = b[:, :, -1:]
    q_in = q * jnp.exp(b)
    k_in = k * jnp.exp(-b)
    k_out = k * jnp.exp(b_last - b)
    A = jnp.einsum('bnihd,bnjhd->bnhij', q_in, k_in)
    causal = jnp.tril(jnp.ones((C, C), dtype=bool))
    A = jnp.where(causal, A, 0.0)
    o_intra = jnp.einsum('bnhij,bnjhe->bnihe', A, v)
    dS = jnp.einsum('bnjhd,bnjhe->nbhde', k_out, v)
    decay = jnp.exp(b_last[:, :, 0]).transpose(1, 0, 2, 3)

    def step(S, inp):
        dS_c, dec_c = inp
        return dec_c[..., None] * S + dS_c, S

    S0 = jnp.zeros((B, H, Dk, Dv), f32)
    _, S_prev = lax.scan(step, S0, (dS, decay))
    o_inter = jnp.einsum('bnihd,nbhde->bnihe', q_in, S_prev)
    return (o_intra + o_inter).reshape(B, T, H, Dv)


def gla_mixer(h, w_in, w_gate_up, b_gate, gla_norm_w):
    B, T, _ = h.shape
    proj = h @ w_in
    cuts = np.cumsum([GLA_HK, GLA_HK, MIXER_WIDTH, GLA_GATE_RANK, MEM_WIDTH]).tolist()
    q, k, v, g_low, q_mem, gate = jnp.split(proj, cuts, axis=-1)
    log_a = jax.nn.log_sigmoid((g_low @ w_gate_up + b_gate).astype(jnp.float32)) / GLA_GATE_TAU
    o = gla_chunked(q.reshape(B, T, GLA_HEADS, GLA_DK),
                    k.reshape(B, T, GLA_HEADS, GLA_DK),
                    v.reshape(B, T, GLA_HEADS, GLA_DV),
                    log_a.reshape(B, T, GLA_HEADS, GLA_DK))
    o = rmsnorm(o, gla_norm_w).astype(h.dtype).reshape(B, T, MIXER_WIDTH)
    return o, q_mem, gate


def dilated_group(q, k, v, window, dilation):
    B, T, H, Dh = q.shape
    r = dilation
    n = window // dilation
    L = T // r
    nb = -(-L // n)
    Lp = nb * n

    def phase_blocks(x):
        x = x.reshape(B, L, r, H, Dh).transpose(0, 2, 3, 1, 4)
        x = jnp.pad(x, ((0, 0), (0, 0), (0, 0), (0, Lp - L), (0, 0)))
        return x.reshape(B, r, H, nb, n, Dh)

    def with_prev(x):
        prev = jnp.pad(x, ((0, 0), (0, 0), (0, 0), (1, 0), (0, 0), (0, 0)))[:, :, :, :-1]
        return jnp.concatenate([prev, x], axis=4)

    qb = phase_blocks(q)
    kw = with_prev(phase_blocks(k))
    vw = with_prev(phase_blocks(v))
    s = jnp.einsum('bphjqd,bphjkd->bphjqk', qb, kw).astype(jnp.float32) * (Dh ** -0.5)
    qi = jnp.arange(n)[:, None] + n
    ki = jnp.arange(2 * n)[None, :]
    dist = qi - ki
    key_abs = jnp.arange(nb)[:, None, None] * n + ki[None] - n
    mask = (dist >= 0)[None] & (dist <= n)[None] & (key_abs >= 0)
    s = jnp.where(mask, s, -jnp.inf)
    m = jnp.max(s, axis=-1, keepdims=True)
    p = jnp.exp(s - m)
    den = jnp.sum(p, axis=-1, keepdims=True)
    o = jnp.einsum('bphjqk,bphjkd->bphjqd', (p / den).astype(v.dtype), vw)
    lse = (m + jnp.log(den))[..., 0]
    o = o.reshape(B, r, H, Lp, Dh)[:, :, :, :L].transpose(0, 3, 1, 2, 4).reshape(B, T, H, Dh)
    lse = lse.reshape(B, r, H, Lp)[..., :L].transpose(0, 3, 1, 2).reshape(B, T, H)
    return o, lse


def dilated_mixer(h, w_in):
    B, T, _ = h.shape
    pos = jnp.arange(T)
    outs, lses = [], []
    for g, (window, dil) in enumerate(DIL_GROUPS):
        base = g * 3 * MIXER_WIDTH
        qkv = (h @ w_in[:, base:base + 3 * MIXER_WIDTH]).reshape(B, T, 3, DIL_HEADS, DIL_HEAD_DIM)
        q = partial_rope(qkv[:, :, 0], pos)
        k = partial_rope(qkv[:, :, 1], pos)
        o, lse = dilated_group(q, k, qkv[:, :, 2], window, dil)
        outs.append(o)
        lses.append(lse)
    wts = jax.nn.softmax(jnp.stack(lses, axis=0), axis=0)
    o = jnp.einsum('gbth,gbthd->bthd', wts, jnp.stack(outs, axis=0).astype(jnp.float32))
    o = o.astype(h.dtype).reshape(B, T, MIXER_WIDTH)
    rest = h @ w_in[:, len(DIL_GROUPS) * 3 * MIXER_WIDTH:]
    q_mem, gate = jnp.split(rest, [MEM_WIDTH], axis=-1)
    return o, q_mem, gate


def setup_inputs(seed: int = 0) -> dict:
    key = jax.random.key(seed)
    ks = jax.random.split(key, 16)
    f32 = jnp.float32
    nrm = lambda k, shape, scale: jax.random.normal(k, shape, f32) * scale
    return {
        "x": nrm(ks[0], (BATCH, SEQ, D_MODEL), 1.0),
        "mem": nrm(ks[1], (BATCH, N_MEM, D_MODEL), 1.0),
        "mem_norm_w": 1.0 + nrm(ks[2], (D_MODEL,), 0.02),
        "norm_w": 1.0 + nrm(ks[3], (DEPTH, D_MODEL), 0.02),
        "w_memkv": nrm(ks[4], (DEPTH, D_MODEL, 2 * MEM_WIDTH), D_MODEL ** -0.5),
        "w_out": nrm(ks[5], (DEPTH, MIX_WIDTH, D_MODEL), MIX_WIDTH ** -0.5),
        "w_in_a": nrm(ks[6], (N_A, D_MODEL, GLA_IN), D_MODEL ** -0.5),
        "w_gate_up": nrm(ks[7], (N_A, GLA_GATE_RANK, GLA_HK), GLA_GATE_RANK ** -0.5),
        "b_gate": nrm(ks[8], (N_A, GLA_HK), 0.1),
        "gla_norm_w": 1.0 + nrm(ks[9], (N_A, GLA_DV), 0.02),
        "w_in_b": nrm(ks[10], (N_B, D_MODEL, DIL_IN), D_MODEL ** -0.5),
        "final_norm_w": 1.0 + nrm(ks[11], (D_MODEL,), 0.02),
    }


def reference(x, mem, mem_norm_w, norm_w, w_memkv, w_out, w_in_a, w_gate_up, b_gate,
              gla_norm_w, w_in_b, final_norm_w):
    mem_n = rmsnorm(mem, mem_norm_w)
    for i in range(DEPTH):
        h = rmsnorm(x, norm_w[i])
        j = i // N_MIXERS
        if i % N_MIXERS == 0:
            mix, q_mem, gate = gla_mixer(h, w_in_a[j], w_gate_up[j], b_gate[j], gla_norm_w[j])
        else:
            mix, q_mem, gate = dilated_mixer(h, w_in_b[j])
        mem_o = memory_attention(q_mem, mem_n, w_memkv[i])
        branch = jnp.concatenate([mix, mem_o], axis=-1) * jax.nn.silu(gate)
        x = x + branch @ w_out[i]
    return rmsnorm(x, final_norm_w)
```

```cpp
#include <hip/hip_runtime.h>
#include <hip/hip_cooperative_groups.h>
#include <cstdio>
namespace cg = cooperative_groups;

#ifndef ONE_LAUNCH
#define ONE_LAUNCH 1
#endif

#ifndef REP_G1
#define REP_G1 1
#endif
#ifndef REP_MIXA
#define REP_MIXA 1
#endif
#ifndef REP_MIXB
#define REP_MIXB 1
#endif
#ifndef REP_BR
#define REP_BR 1
#endif
#ifndef REP_NORM
#define REP_NORM 1
#endif
#define DI __device__ __forceinline__
#define LAS __attribute__((address_space(3)))
typedef unsigned short bf16_t;
typedef short bf16x8 __attribute__((ext_vector_type(8)));
typedef short s16x4 __attribute__((ext_vector_type(4)));
typedef float f32x4 __attribute__((ext_vector_type(4)));
typedef unsigned u32x4 __attribute__((ext_vector_type(4)));
typedef unsigned u32x2 __attribute__((ext_vector_type(2)));
typedef LAS unsigned char* ldsp;

constexpr int BATCH = 32, SEQ = 2048, DM = 1024, MTOK = BATCH * SEQ;
constexpr int GLA_N = 2832, GLA_NP = 3072, DIL_N = 8192;
constexpr int NSLAB = 4, SLAB_B = BATCH / NSLAB, SLAB_ROWS = SLAB_B * SEQ;
constexpr int GA_K = 384, GA_V = 768, GA_GL = 1536, GA_QM = 1552, GA_GATE = 1808;
constexpr int DB_QM = 6912, DB_GATE = 7168;
constexpr int NTHREADS = 512;
constexpr int LDS_WORK = 139264;
constexpr int LDS_BYTES = LDS_WORK + 16;

constexpr size_t WS_WA = 0;
constexpr size_t WS_WB = WS_WA + (size_t)2 * GLA_NP * 1024 * 2;
constexpr size_t WS_WO = WS_WB + (size_t)2 * DIL_N * 1024 * 2;
constexpr size_t WS_WKV = WS_WO + (size_t)4 * 1024 * 1024 * 2;
constexpr size_t WS_MEMN = WS_WKV + (size_t)2048 * 1024 * 2;
constexpr size_t WS_KV = WS_MEMN + (size_t)8192 * 1024 * 2;
constexpr size_t WS_ROPE = WS_KV + (size_t)8192 * 2048 * 2;
constexpr size_t PROJ_SLAB = (size_t)SLAB_ROWS * DIL_N;
constexpr size_t OBUF_SLAB = (size_t)SLAB_ROWS * 2304;
constexpr size_t LSE_SLAB = (size_t)SLAB_ROWS * 18;
constexpr size_t WS_PROJ = WS_ROPE + (size_t)2048 * 16 * 8;
constexpr size_t WS_OBUF = WS_PROJ + 2 * PROJ_SLAB * 2;
constexpr size_t WS_LSE = WS_OBUF + (size_t)MTOK * 768 * 2;
constexpr size_t WS_BR = WS_LSE + 2 * LSE_SLAB * 4;
constexpr size_t DO_H = 0, DO_OBUF2 = (size_t)MTOK * 1024 * 2;
static_assert(2 * PROJ_SLAB >= (size_t)MTOK * GLA_NP && DO_OBUF2 + OBUF_SLAB * 2 <= (size_t)MTOK * 1024 * 4 && OBUF_SLAB <= (size_t)MTOK * 768, "buffer plan");
constexpr size_t WS_BAR = WS_BR + (size_t)MTOK * 1024 * 2;
constexpr size_t WS_SS = WS_BAR + 16384;
constexpr size_t WS_Q0 = WS_SS + (size_t)4 * MTOK * 16 * 4;
constexpr size_t WS_T0P = WS_Q0 + (size_t)BATCH * 768 * 4;
constexpr size_t WS_T0BR = WS_T0P + (size_t)BATCH * 8192 * 4;
constexpr size_t WS_T0X1 = WS_T0BR + (size_t)BATCH * 1024 * 4;
constexpr size_t WS_T0X2 = WS_T0X1 + (size_t)BATCH * 1024 * 4;
constexpr size_t WS_XB = WS_T0X2 + (size_t)BATCH * 1024 * 4;
constexpr size_t WS_END = WS_XB + (size_t)MTOK * 1024 * 2;

struct Params {
    const float *x, *mem, *mem_norm_w, *norm_w, *w_memkv, *w_out, *w_in_a, *w_gate_up, *b_gate, *gla_norm_w, *w_in_b, *final_norm_w;
    float* out; unsigned char* ws; int ph_lo, ph_hi;
};

typedef __bf16 bf16v2_t __attribute__((ext_vector_type(2)));
typedef float f32x2_t __attribute__((ext_vector_type(2)));
DI unsigned cvt_pk_bf16(float lo, float hi) { const f32x2_t v = {lo, hi}; const bf16v2_t b = __builtin_convertvector(v, bf16v2_t); return __builtin_bit_cast(unsigned, b); }
DI float bf_lo(unsigned u) { return __uint_as_float(u << 16); }
DI float bf_hi(unsigned u) { return __uint_as_float(u & 0xffff0000u); }
DI float bf2f(bf16_t b) { return __uint_as_float(((unsigned)b) << 16); }
DI bf16_t f2bf(float f) { return (bf16_t)(cvt_pk_bf16(f, 0.f) & 0xffffu); }
DI f32x4 mfma16(bf16x8 a, bf16x8 b, f32x4 c) { return __builtin_amdgcn_mfma_f32_16x16x32_bf16(a, b, c, 0, 0, 0); }
DI bf16x8 lds_rd8(ldsp p) { return *(LAS bf16x8*)p; }
DI bf16x8 lds_tr8(ldsp p0, ldsp p1) {
    s16x4 lo = __builtin_amdgcn_ds_read_tr16_b64_v4i16((LAS s16x4*)p0);
    s16x4 hi = __builtin_amdgcn_ds_read_tr16_b64_v4i16((LAS s16x4*)p1);
    return __builtin_shufflevector(lo, hi, 0, 1, 2, 3, 4, 5, 6, 7);
}
DI float wave_sum(float v) {
#pragma unroll
    for (int o = 32; o; o >>= 1) v += __shfl_xor(v, o);
    return v;
}
DI float silu_f(float x) { return x / (1.0f + __expf(-x)); }
DI float logsig_f(float x) { return fminf(x, 0.f) - __logf(1.0f + __expf(-fabsf(x))); }


#define XB_TMO      128
#define XB_XCNT(j)  (256  + 64 * (j))
#define XB_XSUB(j)  (1280 + 64 * (j))
#define XB_XGEN(j)  (2304 + 64 * (j))
#define XB_TOP      3328
#define XB_TOPGEN   3392
#define XCD_BAR_WORDS 3456
#define XB_SPIN_CAP (1u << 22)
DI unsigned xb_ld(unsigned* p)              { return __hip_atomic_load(p, __ATOMIC_RELAXED, __HIP_MEMORY_SCOPE_AGENT); }
DI unsigned xb_add(unsigned* p, unsigned v) { return __hip_atomic_fetch_add(p, v, __ATOMIC_RELAXED, __HIP_MEMORY_SCOPE_AGENT); }
DI unsigned xb_xcc_id() { return (unsigned)__builtin_amdgcn_s_getreg((3 << 11) | 20) & 0xFu; }
#define XB_SPIN(cond, bar) do { unsigned _sp = 0; while (cond) { __builtin_amdgcn_s_sleep(1); \
    if ((++_sp & 255u) == 0u) { if (xb_ld(&(bar)[XB_TMO])) break; if (_sp > XB_SPIN_CAP) { atomicAdd(&(bar)[XB_TMO], 1u); break; } } } } while (0)
struct XcdBarrier { unsigned* bar; unsigned x; volatile LAS unsigned* st; };
DI XcdBarrier xcd_barrier_post(unsigned* bar, volatile LAS unsigned* st) {
    XcdBarrier b; b.bar = bar; b.x = xb_xcc_id(); b.st = st;
    if (threadIdx.x == 0) (void)xb_add(&bar[XB_XCNT(b.x)], 1u);
    return b;
}
DI void xcd_barrier_complete(unsigned* bar, unsigned x, unsigned& nloc, unsigned& nx) {
    const unsigned G = gridDim.x * gridDim.y * gridDim.z;
    unsigned sum, cnt, mine, sp = 0u;
    for (;;) {
        sum = 0u; cnt = 0u; mine = 0u;
#pragma unroll
        for (unsigned j = 0; j < 16; ++j) { const unsigned c = xb_ld(&bar[XB_XCNT(j)]); sum += c; cnt += (c > 0u) ? 1u : 0u; mine = (j == x) ? c : mine; }
        if (sum == G) break;
        __builtin_amdgcn_s_sleep(1);
        if ((++sp & 255u) == 0u) { if (xb_ld(&bar[XB_TMO])) break; if (sp > XB_SPIN_CAP) { atomicAdd(&bar[XB_TMO], 1u); break; } }
    }
    nloc = mine > 0u ? mine : 1u; nx = cnt > 0u ? cnt : 1u;
}
DI void xcd_barrier(const XcdBarrier& b) {
    asm volatile("s_waitcnt vmcnt(0)" ::: "memory");
    __syncthreads();
    if (threadIdx.x == 0) {
        unsigned* bar = b.bar;
        __builtin_amdgcn_s_waitcnt(0);
        unsigned nloc = b.st[0], nx = b.st[1];
        if (nloc == 0u) { xcd_barrier_complete(bar, b.x, nloc, nx); b.st[0] = nloc; b.st[1] = nx; }
        const unsigned old = xb_add(&bar[XB_XSUB(b.x)], 1u);
        const unsigned gen = old / nloc;
        if (old + 1u == (gen + 1u) * nloc) {
            __builtin_amdgcn_fence(__ATOMIC_RELEASE, "agent");
            asm volatile("s_waitcnt vmcnt(0)" ::: "memory");
            const unsigned og = xb_add(&bar[XB_TOP], 1u);
            const unsigned tg = og / nx;
            if (og + 1u == (tg + 1u) * nx) xb_add(&bar[XB_TOPGEN], 1u);
            else XB_SPIN(xb_ld(&bar[XB_TOPGEN]) == tg, bar);
            __builtin_amdgcn_fence(__ATOMIC_ACQUIRE, "agent");
            xb_add(&bar[XB_XGEN(b.x)], 1u);
            asm volatile("s_waitcnt vmcnt(0)" ::: "memory");
        } else {
            XB_SPIN(xb_ld(&bar[XB_XGEN(b.x)]) == gen, bar);
            __builtin_amdgcn_fence(__ATOMIC_ACQUIRE, "agent");
            asm volatile("s_waitcnt vmcnt(0)" ::: "memory");
        }
    }
    __syncthreads();
}

namespace pg8 {
constexpr int BM = 256, BK = 64, HALF = 128, HTB = HALF * BK * 2, STAGE_BYTES = 8 * HTB, NXCD = 8, WGM = 8;
DI int lds_byte(int r, int c) { const int st = (r >> 4) * 2 + (c >> 5), rr = r & 15, cc = c & 31, ob = rr * 64 + cc * 2; return st * 1024 + (ob ^ (((ob >> 9) & 1) << 5)); }
DI void stage_rc(int b, int& R, int& C) { const int st = b / 1024, sb = b % 1024, swz = sb ^ (((sb >> 9) & 1) << 5); R = (st >> 1) * 16 + swz / 64; C = (st & 1) * 32 + (swz % 64) / 2; }
DI int perm32(int rho) { const int n = rho >> 4, i = rho & 15; return 8 * (i >> 2) + 4 * n + (i & 3); }
struct Unit { int pm, pn; };
struct Gemm { const bf16_t* A; const bf16_t* Bt; int M, N, K; };
struct StaticOrder {
    int nM, nN, nwg, G, c;
    DI void init(int M, int N, int G_, int c_) { nM = M / BM; nN = N / BM; nwg = nM * nN; G = G_; c = c_; }
    DI bool next(int i, Unit& u) const {
        const long L = (long)i * G + c; if (L >= nwg) return false;
        int wgid = (int)L; { const int q = nwg / NXCD, r = nwg % NXCD, xcd = wgid % NXCD, off = wgid / NXCD; wgid = (xcd < r ? xcd * (q + 1) : r * (q + 1) + (xcd - r) * q) + off; }
        const int nig = WGM * nN, gid = wgid / nig, fm = gid * WGM, gsz = (nM - fm) < WGM ? (nM - fm) : WGM;
        u.pm = fm + ((wgid % nig) % gsz); u.pn = (wgid % nig) / gsz; return true;
    }
};
struct EpiBf {
    static constexpr bool PERM = true;
    bf16_t* O; int ldc;
    DI void operator()(const f32x4 (&acc)[2][2][4][2], const Unit& u, int wr, int wc, int fr, int fq) const {
        const int row0 = u.pm * BM + wr * 64 + fr; const int col0 = u.pn * BM + wc * 32 + 8 * fq;
#pragma unroll
        for (int ai = 0; ai < 2; ++ai)
#pragma unroll
            for (int m = 0; m < 4; ++m) { const int row = row0 + ai * HALF + m * 16; bf16_t* rowp = O + (size_t)row * ldc + col0;
#pragma unroll
                for (int bj = 0; bj < 2; ++bj) { const f32x4 v0 = acc[ai][bj][m][0], v1 = acc[ai][bj][m][1];
                    u32x4 w; w.x = cvt_pk_bf16(v0[0], v0[1]); w.y = cvt_pk_bf16(v0[2], v0[3]); w.z = cvt_pk_bf16(v1[0], v1[1]); w.w = cvt_pk_bf16(v1[2], v1[3]);
                    *(u32x4*)(rowp + bj * HALF) = w; } }
    }
};
struct EpiRes {
    static constexpr bool PERM = true;
    const float* Xf; const bf16_t* Xb; bf16_t* Y;
    DI void operator()(const f32x4 (&acc)[2][2][4][2], const Unit& u, int wr, int wc, int fr, int fq) const {
        const int row0 = u.pm * BM + wr * 64 + fr, col0 = u.pn * BM + wc * 32 + 8 * fq;
        if (Xf) {
#pragma unroll
            for (int ai = 0; ai < 2; ++ai)
#pragma unroll
                for (int mp = 0; mp < 2; ++mp) {
                    f32x4 xf[2][2][2];
#pragma unroll
                    for (int mm = 0; mm < 2; ++mm)
#pragma unroll
                        for (int bj = 0; bj < 2; ++bj) { const float* xp = Xf + (size_t)(row0 + ai * HALF + (2 * mp + mm) * 16) * 1024 + col0 + bj * HALF;
                            xf[mm][bj][0] = *(const f32x4*)xp; xf[mm][bj][1] = *(const f32x4*)(xp + 4); }
#pragma unroll
                    for (int mm = 0; mm < 2; ++mm) { const int m = 2 * mp + mm; const size_t ro = (size_t)(row0 + ai * HALF + m * 16) * 1024 + col0;
#pragma unroll
                        for (int bj = 0; bj < 2; ++bj) {
                            const f32x4 y0 = acc[ai][bj][m][0] + xf[mm][bj][0], y1 = acc[ai][bj][m][1] + xf[mm][bj][1];
                            u32x4 w; w.x = cvt_pk_bf16(y0[0], y0[1]); w.y = cvt_pk_bf16(y0[2], y0[3]); w.z = cvt_pk_bf16(y1[0], y1[1]); w.w = cvt_pk_bf16(y1[2], y1[3]);
                            *(u32x4*)(Y + ro + bj * HALF) = w;
                        }
                    }
                }
        } else {
#pragma unroll
            for (int ai = 0; ai < 2; ++ai) {
                u32x4 xv[4][2];
#pragma unroll
                for (int m = 0; m < 4; ++m)
#pragma unroll
                    for (int bj = 0; bj < 2; ++bj) xv[m][bj] = *(const u32x4*)(Xb + (size_t)(row0 + ai * HALF + m * 16) * 1024 + col0 + bj * HALF);
#pragma unroll
                for (int m = 0; m < 4; ++m) { const size_t ro = (size_t)(row0 + ai * HALF + m * 16) * 1024 + col0;
#pragma unroll
                    for (int bj = 0; bj < 2; ++bj) {
                        const u32x4 x = xv[m][bj];
                        const f32x4 x0 = (f32x4){bf_lo(x.x), bf_hi(x.x), bf_lo(x.y), bf_hi(x.y)}, x1 = (f32x4){bf_lo(x.z), bf_hi(x.z), bf_lo(x.w), bf_hi(x.w)};
                        const f32x4 y0 = acc[ai][bj][m][0] + x0, y1 = acc[ai][bj][m][1] + x1;
                        u32x4 w; w.x = cvt_pk_bf16(y0[0], y0[1]); w.y = cvt_pk_bf16(y0[2], y0[3]); w.z = cvt_pk_bf16(y1[0], y1[1]); w.w = cvt_pk_bf16(y1[2], y1[3]);
                        *(u32x4*)(Y + ro + bj * HALF) = w;
                    }
                }
            }
        }
    }
};

struct PanelOrder {
    int pm;
    DI bool next(int i, Unit& u) const { if (i >= 4) return false; u.pm = pm; u.pn = i; return true; }
};
template <class Epi, class Sched>
DI void gemm_phase(ldsp lds, const Gemm g, const Sched& S, const Epi& E, const int tid) {
    const int wid = __builtin_amdgcn_readfirstlane(tid >> 6), lane = tid & 63, wr = wid >> 2, wc = wid & 3, fr = lane & 15, fq = lane >> 4;
    const int K = g.K, nt = K / BK;
    unsigned voffA[2], voffB[2];
#pragma unroll
    for (int i = 0; i < 2; ++i) { int R, C; stage_rc(tid * 16 + i * 8192, R, C); const int Rb = Epi::PERM ? ((R & ~31) + perm32(R & 31)) : R;
        voffA[i] = (unsigned)(R * K + C) * 2u; voffB[i] = (unsigned)(Rb * K + C) * 2u; }
    const size_t kstep = (size_t)(BK * 2);
    const size_t hstep = (size_t)HALF * K * 2;
    const size_t tstep = 2 * hstep;
    const unsigned ldsw = (unsigned)wid * 1024u;
    const int aoff = lds_byte(wr * 64 + fr, fq * 8), boff = lds_byte(wc * 32 + fr, fq * 8);
#define PG8_SA(b, h) (((b) * 2 + (h)) * HTB)
#define PG8_SB(b, h) ((4 + (b) * 2 + (h)) * HTB)
#define PG8_STAGE(bufoff, gbase, voff) do { _Pragma("unroll") for (int _i = 0; _i < 2; ++_i) \
        __builtin_amdgcn_global_load_lds((const unsigned*)((const char*)(gbase) + (voff)[_i]), (LAS unsigned*)(lds + (bufoff) + ldsw + _i * 8192), 16, 0, 0); } while (0)
#define PG8_LDA(dst, b, h) do { _Pragma("unroll") for (int m = 0; m < 4; ++m) _Pragma("unroll") for (int k = 0; k < 2; ++k) dst[m][k] = *(const LAS bf16x8*)(lds + PG8_SA(b, h) + aoff + m * 2048 + k * 1024); } while (0)
#define PG8_LDB(dst, b, h) do { _Pragma("unroll") for (int n = 0; n < 2; ++n) _Pragma("unroll") for (int k = 0; k < 2; ++k) dst[n][k] = *(const LAS bf16x8*)(lds + PG8_SB(b, h) + boff + n * 2048 + k * 1024); } while (0)
#define PG8_MMA(ai, bj, At, Bt) do { __builtin_amdgcn_s_setprio(1); _Pragma("unroll") for (int m = 0; m < 4; ++m) _Pragma("unroll") for (int n = 0; n < 2; ++n) _Pragma("unroll") for (int k = 0; k < 2; ++k) \
        acc[ai][bj][m][n] = __builtin_amdgcn_mfma_f32_16x16x32_bf16(Bt[n][k], At[m][k], acc[ai][bj][m][n], 0, 0, 0); __builtin_amdgcn_s_setprio(0); } while (0)
#define PG8_WAIT_V(n) asm volatile("s_waitcnt vmcnt(" #n ")" ::: "memory")
#define PG8_WAIT_L(n) asm volatile("s_waitcnt lgkmcnt(" #n ")" ::: "memory")
#define PG8_BAR __builtin_amdgcn_s_barrier()
#define PG8_SCHED __builtin_amdgcn_sched_barrier(0)
    Unit cur, nxt; int ui = 0;
    if (!S.next(0, cur)) return;
    f32x4 acc[2][2][4][2];
#pragma unroll
    for (int a = 0; a < 2; ++a)
#pragma unroll
        for (int b = 0; b < 2; ++b)
#pragma unroll
            for (int m = 0; m < 4; ++m)
#pragma unroll
                for (int n = 0; n < 2; ++n) acc[a][b][m][n] = (f32x4){0.f, 0.f, 0.f, 0.f};
    bf16x8 At[4][2], B0[2][2], B1[2][2];
    const char* cA = (const char*)g.A + (size_t)cur.pm * tstep; const char* cB = (const char*)g.Bt + (size_t)cur.pn * tstep;
    PG8_STAGE(PG8_SB(0, 0), cB, voffB); PG8_STAGE(PG8_SA(0, 0), cA, voffA); PG8_STAGE(PG8_SB(0, 1), cB + hstep, voffB); PG8_STAGE(PG8_SA(0, 1), cA + hstep, voffA);
    if (wr == 1) PG8_BAR;
    PG8_WAIT_V(4); PG8_BAR;
    PG8_STAGE(PG8_SB(1, 0), cB + kstep, voffB); PG8_STAGE(PG8_SA(1, 0), cA + kstep, voffA); PG8_STAGE(PG8_SB(1, 1), cB + hstep + kstep, voffB);
    PG8_WAIT_V(6); PG8_BAR;
    for (;;) {
        const bool has_next = S.next(ui + 1, nxt);
        const char* nA = has_next ? (const char*)g.A + (size_t)nxt.pm * tstep : cA; const char* nB = has_next ? (const char*)g.Bt + (size_t)nxt.pn * tstep : cB;
        for (int t = 0; t < nt; t += 2) {
            const bool last = (t == nt - 2);
            const char* a1 = cA + (size_t)(t + 1) * kstep;
            const char* a2 = last ? nA : cA + (size_t)(t + 2) * kstep; const char* b2 = last ? nB : cB + (size_t)(t + 2) * kstep;
            const char* a3 = a2 + kstep; const char* b3 = b2 + kstep;
            PG8_LDB(B0, 0, 0); PG8_SCHED; PG8_LDA(At, 0, 0); PG8_STAGE(PG8_SA(1, 1), a1 + hstep, voffA);
            PG8_WAIT_L(8); PG8_BAR; PG8_WAIT_L(0); PG8_MMA(0, 0, At, B0); PG8_BAR; PG8_SCHED;
            PG8_LDB(B1, 0, 1); PG8_STAGE(PG8_SB(0, 0), b2, voffB);
            PG8_BAR; PG8_WAIT_L(0); PG8_MMA(0, 1, At, B1); PG8_BAR;
            PG8_LDA(At, 0, 1); PG8_STAGE(PG8_SA(0, 0), a2, voffA);
            PG8_BAR; PG8_WAIT_L(0); PG8_MMA(1, 0, At, B0); PG8_BAR; PG8_SCHED;
            PG8_STAGE(PG8_SB(0, 1), b2 + hstep, voffB);
            PG8_WAIT_V(6); PG8_BAR; PG8_MMA(1, 1, At, B1); PG8_BAR;
            PG8_LDB(B0, 1, 0); PG8_SCHED; PG8_LDA(At, 1, 0); PG8_STAGE(PG8_SA(0, 1), a2 + hstep, voffA);
            PG8_WAIT_L(8); PG8_BAR; PG8_WAIT_L(0); PG8_MMA(0, 0, At, B0); PG8_BAR; PG8_SCHED;
            PG8_LDB(B1, 1, 1); PG8_STAGE(PG8_SB(1, 0), b3, voffB);
            PG8_BAR; PG8_WAIT_L(0); PG8_MMA(0, 1, At, B1); PG8_BAR;
            PG8_LDA(At, 1, 1); PG8_STAGE(PG8_SA(1, 0), a3, voffA);
            PG8_BAR; PG8_WAIT_L(0); PG8_MMA(1, 0, At, B0); PG8_BAR; PG8_SCHED;
            PG8_STAGE(PG8_SB(1, 1), b3 + hstep, voffB);
            PG8_WAIT_V(6); PG8_BAR; PG8_MMA(1, 1, At, B1); PG8_BAR;
        }
        E(acc, cur, wr, wc, fr, fq);
        if (!has_next) break;
#pragma unroll
        for (int a = 0; a < 2; ++a)
#pragma unroll
            for (int b = 0; b < 2; ++b)
#pragma unroll
                for (int m = 0; m < 4; ++m)
#pragma unroll
                    for (int n = 0; n < 2; ++n) acc[a][b][m][n] = (f32x4){0.f, 0.f, 0.f, 0.f};
        cur = nxt; cA = nA; cB = nB; ++ui;
    }
    PG8_WAIT_V(0);
    if (wr == 0) PG8_BAR;
    PG8_BAR;
#undef PG8_SA
#undef PG8_SB
#undef PG8_STAGE
#undef PG8_LDA
#undef PG8_LDB
#undef PG8_MMA
#undef PG8_WAIT_V
#undef PG8_WAIT_L
#undef PG8_BAR
#undef PG8_SCHED
}
}

enum { T_PRO = 0, T_KV, T_G1, T_MIX, T_BR, T_G2, T_NORM, T_NONE };
struct Step { int type, layer, b0, nb; };
__host__ __device__ inline Step decode_step(int s) {
    if (s == 0) return Step{T_PRO, 0, 0, 0};
    if (s == 1) return Step{T_KV, 0, 0, 0};
    s -= 2;
    for (int L = 0; L < 4; ++L) {
        const bool gla = (L % 2) == 0;
        if (gla) {
            if (s < 5) return Step{T_G1 + s, L, 0, BATCH};
            s -= 5;
        } else {
            if (s < 2 * NSLAB) return Step{(s & 1) ? T_MIX : T_G1, L, (s >> 1) * SLAB_B, SLAB_B};
            if (s < 2 * NSLAB + 3) return Step{T_BR + (s - 2 * NSLAB), L, (NSLAB - 1) * SLAB_B, s == 2 * NSLAB ? SLAB_B : BATCH};
            s -= 2 * NSLAB + 3;
        }
    }
    return Step{T_NONE, 0, 0, 0};
}
constexpr int NSTEPS = 2 + 2 * 5 + 2 * (2 * NSLAB + 3);

DI void transpose_w(ldsp lds, const float* W, int N, int Npad, bf16_t* Wt, int tid, const float* kscale = nullptr) {
    const int ntn = Npad / 256, ntiles = ntn * 16;
    LAS float* T = (LAS float*)lds;
    for (int t = blockIdx.x; t < ntiles; t += gridDim.x) {
        const int tn = t % ntn, tk = t / ntn, n0 = tn * 256, k0 = tk * 64;
        float4 v[8];
#pragma unroll
        for (int i = 0; i < 8; ++i) {
            const int e = tid + i * 512, kr = e >> 6, c4 = e & 63, n = n0 + c4 * 4;
            v[i] = make_float4(0.f, 0.f, 0.f, 0.f);
            if (n < N) v[i] = *(const float4*)(W + (size_t)(k0 + kr) * N + n);
        }
#pragma unroll
        for (int i = 0; i < 8; ++i) {
            const int e = tid + i * 512, kr = e >> 6, c4 = e & 63;
            *(LAS f32x4*)(T + kr * 260 + c4 * 4) = (f32x4){v[i].x, v[i].y, v[i].z, v[i].w};
        }
        __syncthreads();
#pragma unroll
        for (int i = 0; i < 4; ++i) {
            const int o = tid + i * 512, n = o & 255, kc = o >> 8;
            float f[8];
#pragma unroll
            for (int j = 0; j < 8; ++j) f[j] = T[(kc * 8 + j) * 260 + n];
            if (kscale) {
#pragma unroll
                for (int j = 0; j < 8; ++j) f[j] *= kscale[k0 + kc * 8 + j]; }
            u32x4 w; w.x = cvt_pk_bf16(f[0], f[1]); w.y = cvt_pk_bf16(f[2], f[3]); w.z = cvt_pk_bf16(f[4], f[5]); w.w = cvt_pk_bf16(f[6], f[7]);
            *(u32x4*)(Wt + (size_t)(n0 + n) * 1024 + k0 + kc * 8) = w;
        }
        __syncthreads();
    }
}

template <bool OUT_BF>
DI void norm_rows(const float* src, const float* w, void* dst, int nrows, int wid, int lane, int gw = -1, int nw = 0) {
    if (gw < 0) { gw = blockIdx.x * 8 + wid; nw = gridDim.x * 8; }
    float4 wv[4];
#pragma unroll
    for (int i = 0; i < 4; ++i) wv[i] = *(const float4*)(w + i * 256 + lane * 4);
    for (int rb = gw; rb < nrows; rb += 2 * nw) {
        float4 v[2][4];
#pragma unroll
        for (int q = 0; q < 2; ++q) { const int r = rb + q * nw; const float4* s = (const float4*)(src + (size_t)(r < nrows ? r : rb) * 1024);
#pragma unroll
            for (int i = 0; i < 4; ++i) v[q][i] = s[i * 64 + lane]; }
#pragma unroll
        for (int q = 0; q < 2; ++q) {
            const int r = rb + q * nw;
            float ss = 0.f;
#pragma unroll
            for (int i = 0; i < 4; ++i) ss += v[q][i].x * v[q][i].x + v[q][i].y * v[q][i].y + v[q][i].z * v[q][i].z + v[q][i].w * v[q][i].w;
            ss = wave_sum(ss);
            const float rs = rsqrtf(ss * (1.0f / 1024.0f) + 1e-6f);
            if (r < nrows) {
#pragma unroll
                for (int i = 0; i < 4; ++i) {
                    const float y0 = v[q][i].x * rs * wv[i].x, y1 = v[q][i].y * rs * wv[i].y, y2 = v[q][i].z * rs * wv[i].z, y3 = v[q][i].w * rs * wv[i].w;
                    if (OUT_BF) { u32x2 o; o.x = cvt_pk_bf16(y0, y1); o.y = cvt_pk_bf16(y2, y3); *(u32x2*)((bf16_t*)dst + (size_t)r * 1024 + i * 256 + lane * 4) = o; }
                    else { *(float4*)((float*)dst + (size_t)r * 1024 + i * 256 + lane * 4) = make_float4(y0, y1, y2, y3); }
                }
            }
        }
    }
}

template <bool OUT_BF>
DI void norm_rows_bf(const bf16_t* src, const float* w, void* dst, int nrows, int lane, int gw, int nw) {
    f32x4 wv[4];
#pragma unroll
    for (int i = 0; i < 2; ++i) { wv[2 * i] = *(const f32x4*)(w + i * 512 + lane * 8); wv[2 * i + 1] = *(const f32x4*)(w + i * 512 + lane * 8 + 4); }
    for (int rb = gw; rb < nrows; rb += 4 * nw) {
        u32x4 a[4][2];
#pragma unroll
        for (int q = 0; q < 4; ++q) { const int r = rb + q * nw; const bf16_t* sp = src + (size_t)(r < nrows ? r : rb) * 1024;
            a[q][0] = *(const u32x4*)(sp + lane * 8); a[q][1] = *(const u32x4*)(sp + 512 + lane * 8); }
#pragma unroll
        for (int q = 0; q < 4; ++q) {
            const int r = rb + q * nw;
            float v[16]; float ss = 0.f;
#pragma unroll
            for (int i = 0; i < 2; ++i)
#pragma unroll
                for (int e = 0; e < 4; ++e) { v[8 * i + 2 * e] = bf_lo(a[q][i][e]); v[8 * i + 2 * e + 1] = bf_hi(a[q][i][e]); }
#pragma unroll
            for (int e = 0; e < 16; ++e) ss += v[e] * v[e];
            ss = wave_sum(ss);
            const float rs = rsqrtf(ss * (1.0f / 1024.0f) + 1e-6f);
            if (r < nrows) {
#pragma unroll
                for (int i = 0; i < 2; ++i) {
                    float y[8];
#pragma unroll
                    for (int e = 0; e < 8; ++e) y[e] = v[8 * i + e] * rs * wv[2 * i + (e >> 2)][e & 3];
                    if (OUT_BF) { u32x4 o; o.x = cvt_pk_bf16(y[0], y[1]); o.y = cvt_pk_bf16(y[2], y[3]); o.z = cvt_pk_bf16(y[4], y[5]); o.w = cvt_pk_bf16(y[6], y[7]);
                        *(u32x4*)((bf16_t*)dst + (size_t)r * 1024 + i * 512 + lane * 8) = o; }
                    else { float* d = (float*)dst + (size_t)r * 1024 + i * 512 + lane * 8; *(f32x4*)d = (f32x4){y[0], y[1], y[2], y[3]}; *(f32x4*)(d + 4) = (f32x4){y[4], y[5], y[6], y[7]}; }
                }
            }
        }
    }
}

DI void cast_rows(const float* src, bf16_t* dst, float* ss, int nrows, int wid, int lane) {
    const int gw = blockIdx.x * 8 + wid, nw = gridDim.x * 8;
    for (int r = gw; r < nrows; r += nw) {
        const float4* sp = (const float4*)(src + (size_t)r * 1024);
        float acc = 0.f;
#pragma unroll
        for (int i = 0; i < 4; ++i) { const float4 v = sp[i * 64 + lane]; acc += v.x * v.x + v.y * v.y + v.z * v.z + v.w * v.w;
            u32x2 o; o.x = cvt_pk_bf16(v.x, v.y); o.y = cvt_pk_bf16(v.z, v.w); *(u32x2*)(dst + (size_t)r * 1024 + i * 256 + lane * 4) = o; }
        acc = wave_sum(acc);
        if (lane < 16) ss[(size_t)r * 16 + lane] = lane == 0 ? acc : 0.f;
    }
}

DI void token0_task(ldsp lds, const float* xcur, size_t xstride, const float* nw, const float* win, float* q0k0, int task, int tid, int wid, int lane) {
    const int b = task >> 3, grp = task & 7;
    LAS float* HX = (LAS float*)lds; LAS float* PART = HX + 1024; LAS float* RED = PART + 21 * 96;
    const float* xr = xcur + (size_t)b * xstride;
    const float v0 = xr[tid], v1 = xr[tid + 512];
    const float sq = wave_sum(v0 * v0 + v1 * v1);
    if (lane == 0) RED[wid] = sq;
    __syncthreads();
    float tot = 0.f;
#pragma unroll
    for (int i = 0; i < 8; ++i) tot += RED[i];
    const float rs = rsqrtf(tot * (1.0f / 1024.0f) + 1e-6f);
    HX[tid] = v0 * rs * nw[tid]; HX[tid + 512] = v1 * rs * nw[tid + 512];
    __syncthreads();
    if (tid < 504) {
        const int g4 = tid % 24, sl = tid / 24, k_lo = sl * 49, k_hi = (k_lo + 49 < 1024) ? k_lo + 49 : 1024;
        f32x4 acc = (f32x4){0.f, 0.f, 0.f, 0.f};
        const float* wp = win + (size_t)k_lo * GLA_N + grp * 96 + g4 * 4;
#pragma unroll 7
        for (int k = k_lo; k < k_hi; ++k, wp += GLA_N) { const f32x4 w = *(const f32x4*)wp; acc += w * HX[k]; }
        *(LAS f32x4*)(PART + sl * 96 + g4 * 4) = acc;
    }
    __syncthreads();
    if (tid < 96) { float a = 0.f;
#pragma unroll
        for (int sl = 0; sl < 21; ++sl) a += PART[sl * 96 + tid];
        q0k0[b * 768 + grp * 96 + tid] = a; }
    __syncthreads();
}


typedef float f32x16 __attribute__((ext_vector_type(16)));
constexpr int T0_XS = 1028;
DI void tok0_gemv(ldsp lds, const float* src, size_t sstride, const float* nw, const float* W, int N, float* Y, int ldy, const float* resid, size_t rstride, int task, int tid, int wid, int lane) {
    LAS float* XS = (LAS float*)lds;
    {
        float4 v[4][4];
#pragma unroll
        for (int q = 0; q < 4; ++q) { const float* xr = src + (size_t)(wid + 8 * q) * sstride;
#pragma unroll
            for (int i = 0; i < 4; ++i) v[q][i] = *(const float4*)(xr + i * 256 + lane * 4); }
        float4 w4[4];
#pragma unroll
        for (int i = 0; i < 4; ++i) { w4[i] = make_float4(1.f, 1.f, 1.f, 1.f); if (nw) w4[i] = *(const float4*)(nw + i * 256 + lane * 4); }
#pragma unroll
        for (int q = 0; q < 4; ++q) {
            const int r = wid + 8 * q;
            float ss = 0.f;
#pragma unroll
            for (int i = 0; i < 4; ++i) ss += v[q][i].x * v[q][i].x + v[q][i].y * v[q][i].y + v[q][i].z * v[q][i].z + v[q][i].w * v[q][i].w;
            float rs = 1.0f;
            if (nw) { ss = wave_sum(ss); rs = rsqrtf(ss * (1.0f / 1024.0f) + 1e-6f); }
#pragma unroll
            for (int i = 0; i < 4; ++i)
                *(LAS f32x4*)(XS + r * T0_XS + i * 256 + lane * 4) = (f32x4){v[q][i].x * rs * w4[i].x, v[q][i].y * rs * w4[i].y, v[q][i].z * rs * w4[i].z, v[q][i].w * rs * w4[i].w};
        }
    }
    __syncthreads();
    const int c0 = task * 32, l31 = lane & 31, kk = lane >> 5, col = c0 + l31; const bool cv = col < N;
    const int kb = wid * 128;
    float wv[64];
#pragma unroll
    for (int q = 0; q < 16; ++q)
#pragma unroll
        for (int e = 0; e < 4; ++e) wv[q * 4 + e] = cv ? W[(size_t)(kb + 8 * q + 4 * kk + e) * N + col] : 0.f;
    f32x16 acc;
#pragma unroll
    for (int i = 0; i < 16; ++i) acc[i] = 0.f;
#pragma unroll
    for (int q = 0; q < 16; ++q) {
        const f32x4 a4 = *(LAS f32x4*)(XS + l31 * T0_XS + kb + 8 * q + 4 * kk);
#pragma unroll
        for (int e = 0; e < 4; ++e) acc = __builtin_amdgcn_mfma_f32_32x32x2f32(a4[e], wv[q * 4 + e], acc, 0, 0, 0);
    }
    __syncthreads();
    LAS float* RED = (LAS float*)lds;
#pragma unroll
    for (int i = 0; i < 16; ++i) RED[(wid * 32 + ((i & 3) + 8 * (i >> 2) + 4 * kk)) * 32 + l31] = acc[i];
    __syncthreads();
    for (int o = tid; o < 1024; o += 512) {
        const int b = o >> 5, c = o & 31, cc = c0 + c;
        float t = 0.f;
#pragma unroll
        for (int w = 0; w < 8; ++w) t += RED[(w * 32 + b) * 32 + c];
        if (cc < N) { if (resid) t += resid[(size_t)b * rstride + cc]; Y[(size_t)b * ldy + cc] = t; }
    }
    __syncthreads();
}
DI void tok0_mem(ldsp lds, const float* qm, const float* memb, const float* mnw, const float* Wkv, int hm, LAS float* out64, int tid, int wid, int lane) {
    LAS float* U = (LAS float*)lds; LAS float* SC = U + 1024; LAS float* RSN = SC + 256; LAS float* MB = RSN + 256; LAS float* QS = MB + 2048; LAS float* PO = QS + 64;
    if (tid < 64) QS[tid] = qm[tid];
    __syncthreads();
#pragma unroll
    for (int h2 = 0; h2 < 2; ++h2) {
        const int j = tid + h2 * 512; const float* wr = Wkv + (size_t)j * 512 + hm * 64; float t = 0.f;
#pragma unroll
        for (int d4 = 0; d4 < 16; ++d4) { const float4 w4 = *(const float4*)(wr + d4 * 4); const f32x4 q4 = *(LAS f32x4*)(QS + d4 * 4); t += w4.x * q4[0] + w4.y * q4[1] + w4.z * q4[2] + w4.w * q4[3]; }
        U[j] = t * mnw[j];
    }
    __syncthreads();
    {
        f32x4 u4[4];
#pragma unroll
        for (int q = 0; q < 4; ++q) u4[q] = *(LAS f32x4*)(U + q * 256 + lane * 4);
        for (int i0 = 0; i0 < 32; i0 += 4) {
            float4 m4[4][4];
#pragma unroll
            for (int r = 0; r < 4; ++r) { const float* mr = memb + (size_t)(wid * 32 + i0 + r) * 1024;
#pragma unroll
                for (int q = 0; q < 4; ++q) m4[r][q] = *(const float4*)(mr + q * 256 + lane * 4); }
#pragma unroll
            for (int r = 0; r < 4; ++r) {
                const int n = wid * 32 + i0 + r; float dd = 0.f, ss = 0.f;
#pragma unroll
                for (int q = 0; q < 4; ++q) { const float4 m = m4[r][q];
                    dd += m.x * u4[q][0] + m.y * u4[q][1] + m.z * u4[q][2] + m.w * u4[q][3]; ss += m.x * m.x + m.y * m.y + m.z * m.z + m.w * m.w; }
                dd = wave_sum(dd); ss = wave_sum(ss);
                if (lane == 0) { const float rstd = rsqrtf(ss * (1.0f / 1024.0f) + 1e-6f); SC[n] = dd * rstd * 0.125f; RSN[n] = rstd; }
            }
        }
    }
    __syncthreads();
    if (wid == 0) {
        float sv[4]; float mx = -INFINITY;
#pragma unroll
        for (int i = 0; i < 4; ++i) { sv[i] = SC[lane + 64 * i]; mx = fmaxf(mx, sv[i]); }
#pragma unroll
        for (int o = 32; o; o >>= 1) mx = fmaxf(mx, __shfl_xor(mx, o));
        float sum = 0.f;
#pragma unroll
        for (int i = 0; i < 4; ++i) { sv[i] = __expf(sv[i] - mx); sum += sv[i]; }
        sum = wave_sum(sum);
        const float is = 1.0f / sum;
#pragma unroll
        for (int i = 0; i < 4; ++i) SC[lane + 64 * i] = sv[i] * is * RSN[lane + 64 * i];
    }
    __syncthreads();
    {
        const int j4 = (tid & 255) * 4, nh = tid >> 8;
        f32x4 acc = (f32x4){0.f, 0.f, 0.f, 0.f};
#pragma unroll 8
        for (int n = nh * 128; n < nh * 128 + 128; ++n) { const float4 m4 = *(const float4*)(memb + (size_t)n * 1024 + j4); const float c = SC[n]; acc[0] += m4.x * c; acc[1] += m4.y * c; acc[2] += m4.z * c; acc[3] += m4.w * c; }
        *(LAS f32x4*)(MB + nh * 1024 + j4) = acc;
    }
    __syncthreads();
#pragma unroll
    for (int h2 = 0; h2 < 2; ++h2) { const int j = tid + h2 * 512; U[j] = (MB[j] + MB[1024 + j]) * mnw[j]; }
    __syncthreads();
    {
        const int d4 = tid & 15, js = tid >> 4;
        f32x4 o = (f32x4){0.f, 0.f, 0.f, 0.f};
#pragma unroll 8
        for (int j = js * 32; j < js * 32 + 32; ++j) { const float4 w4 = *(const float4*)(Wkv + (size_t)j * 512 + 256 + hm * 64 + d4 * 4); const float m = U[j]; o[0] += w4.x * m; o[1] += w4.y * m; o[2] += w4.z * m; o[3] += w4.w * m; }
        *(LAS f32x4*)(PO + js * 64 + d4 * 4) = o;
    }
    __syncthreads();
    if (tid < 64) { float t = 0.f;
#pragma unroll
        for (int js = 0; js < 32; ++js) t += PO[js * 64 + tid];
        out64[tid] = t; }
    __syncthreads();
}
DI void tok0_mix_gla(ldsp lds, const Params& p, const float* P, float* BRo, int task, int tid, int wid, int lane) {
    const int b = task >> 2, hm = task & 3;
    const float* pr = P + (size_t)b * 8192;
    LAS float* OUT = (LAS float*)(lds + 65536); LAS float* R3 = OUT + 64;
    tok0_mem(lds, pr + GA_QM + hm * 64, p.mem + (size_t)b * 256 * 1024, p.mem_norm_w, p.w_memkv, hm, OUT, tid, wid, lane);
    if (tid < 64) BRo[(size_t)b * 1024 + 768 + hm * 64 + tid] = OUT[tid] * silu_f(pr[GA_GATE + 768 + hm * 64 + tid]);
    const float* qp = pr + hm * 96; const float* kp = pr + GA_K + hm * 96;
    const float a = wave_sum(qp[lane] * kp[lane] + (lane < 32 ? qp[64 + lane] * kp[64 + lane] : 0.f)) * 0.10206207261596575f;
    float ve = 0.f;
    if (tid < 192) ve = pr[GA_V + hm * 192 + tid];
    const float sq = wave_sum(ve * ve);
    if (lane == 0 && wid < 3) R3[wid] = sq;
    __syncthreads();
    const float msv = (R3[0] + R3[1] + R3[2]) * (1.0f / 192.0f);
    const float rs = rsqrtf(a * a * msv + 1e-6f);
    if (tid < 192) BRo[(size_t)b * 1024 + hm * 192 + tid] = a * ve * rs * p.gla_norm_w[tid] * silu_f(pr[GA_GATE + hm * 192 + tid]);
    __syncthreads();
}
DI void tok0_mix_dil(ldsp lds, const Params& p, const float* P, float* BRo, int task, int tid, int wid, int lane) {
    const int b = task >> 2, hm = task & 3;
    const float* pr = P + (size_t)b * 8192;
    LAS float* OUT = (LAS float*)(lds + 65536); LAS float* S18 = OUT + 64;
    tok0_mem(lds, pr + DB_QM + hm * 64, p.mem + (size_t)b * 256 * 1024, p.mem_norm_w, p.w_memkv + (size_t)1024 * 512, hm, OUT, tid, wid, lane);
    if (tid < 64) BRo[(size_t)b * 1024 + 768 + hm * 64 + tid] = OUT[tid] * silu_f(pr[DB_GATE + 768 + hm * 64 + tid]);
    if (hm == 0) {
        for (int pi = wid; pi < 18; pi += 8) {
            const int g = pi / 6, head = pi - g * 6;
            const float* qp = pr + g * 2304 + head * 128; const float* kp = qp + 768;
            const float t = wave_sum(qp[lane] * kp[lane] + qp[64 + lane] * kp[64 + lane]) * 0.08838834764831845f;
            if (lane == 0) S18[pi] = t;
        }
        __syncthreads();
        for (int c = tid; c < 768; c += 512) {
            const int head = c >> 7;
            const float l0 = S18[head], l1 = S18[6 + head], l2 = S18[12 + head];
            const float m = fmaxf(l0, fmaxf(l1, l2));
            float e0 = __expf(l0 - m), e1 = __expf(l1 - m), e2 = __expf(l2 - m);
            const float is = 1.0f / (e0 + e1 + e2);
            const float o = (e0 * pr[1536 + c] + e1 * pr[2304 + 1536 + c] + e2 * pr[4608 + 1536 + c]) * is;
            BRo[(size_t)b * 1024 + c] = o * silu_f(pr[DB_GATE + c]);
        }
    }
    __syncthreads();
}

struct DilItem { int g, head, bl, r, ph, jb, s_k0, qcol; size_t rowbase; };
DI DilItem dil_decode(int item) {
    DilItem d;
    const int jb16 = (item + (item >> 8)) & 15; int rest = item >> 4; d.g = rest % 3; rest /= 3; d.head = rest % 6; d.bl = rest / 6;
    const int rsh = 2 * d.g, nbk = 16 >> rsh; d.r = 1 << rsh; d.ph = jb16 >> (4 - rsh); d.jb = jb16 & (nbk - 1);
    d.rowbase = (size_t)d.bl * 2048; d.qcol = d.g * 2304 + d.head * 128; d.s_k0 = 128 * d.jb - 128;
    return d;
}
struct DilPre { u32x4 kc[6], vv[8]; };
constexpr int DIL_KS = 272;

DI void dil_load(DilPre& P, const bf16_t* proj, int item, int tid, int wid, int lane) {
    const DilItem d = dil_decode(item);
    const int kcol = d.qcol + 768, vcol = d.qcol + 1536;
    const u32x4 z = (u32x4){0u, 0u, 0u, 0u};
#pragma unroll
    for (int i = 0; i < 6; ++i) {
        const int e = tid + i * 512, row = e / 12, ch = 4 + (e - row * 12), sp = d.s_k0 + row;
        P.kc[i] = z;
        if (sp >= 0) P.kc[i] = *(const u32x4*)(proj + (d.rowbase + sp * d.r + d.ph) * DIL_N + kcol + ch * 8);
    }
#pragma unroll
    for (int i = 0; i < 8; ++i) {
        const int e = tid + i * 512, row = e >> 4, ch = e & 15, sp = d.s_k0 + row;
        P.vv[i] = z;
        if (sp >= 0) P.vv[i] = *(const u32x4*)(proj + (d.rowbase + sp * d.r + d.ph) * DIL_N + vcol + ch * 8);
    }
}

DI void dil_store(const DilPre& P, bf16x8 (&qf)[4], ldsp lds, const bf16_t* proj, const float* rope, int item, int tid, int wid, int lane) {
    const DilItem d = dil_decode(item);
    const ldsp Kb = lds, Vb = lds + 256 * DIL_KS;
    const int li = lane & 15, quad = lane >> 4;
    const int tq = (128 * d.jb + 16 * wid + li) * d.r + d.ph;
    float4 qcs[4], kcs[4];
    {
        const bf16_t* qsrc = proj + (d.rowbase + tq) * DIL_N + d.qcol + quad * 8;
#pragma unroll
        for (int ks = 0; ks < 4; ++ks) qf[ks] = *(const bf16x8*)(qsrc + ks * 32);
        const float4* rp = (const float4*)(rope + (size_t)tq * 32 + 16 * (quad & 1));
#pragma unroll
        for (int jj = 0; jj < 4; ++jj) qcs[jj] = rp[jj];
    }
    const int prow = tid >> 1, pc = tid & 1, psp = d.s_k0 + prow;
    u32x4 kp1 = (u32x4){0u, 0u, 0u, 0u}, kp2 = kp1;
    {
        const int tok = (psp >= 0 ? psp : 0) * d.r + d.ph;
        const bf16_t* ksrc = proj + (d.rowbase + tok) * DIL_N + d.qcol + 768 + 8 * pc;
        kp1 = *(const u32x4*)ksrc; kp2 = *(const u32x4*)(ksrc + 16);
        const float4* rp = (const float4*)(rope + (size_t)tok * 32 + 16 * pc);
#pragma unroll
        for (int jj = 0; jj < 4; ++jj) kcs[jj] = rp[jj];
    }
#pragma unroll
    for (int i = 0; i < 6; ++i) {
        const int e = tid + i * 512, row = e / 12, ch = 4 + (e - row * 12), sp = d.s_k0 + row;
        if (sp >= 0) *(LAS u32x4*)(Kb + row * DIL_KS + ch * 16) = P.kc[i];
    }
#pragma unroll
    for (int i = 0; i < 8; ++i) {
        const int e = tid + i * 512, row = e >> 4, ch = e & 15, sp = d.s_k0 + row;
        if (sp >= 0) *(LAS u32x4*)(Vb + row * DIL_KS + ch * 16) = P.vv[i];
    }
    if (psp >= 0) {
        u32x4 o1, o2;
#pragma unroll
        for (int jj = 0; jj < 4; ++jj) {
            const float4 cs = kcs[jj];
            const float a0 = bf_lo(kp1[jj]), a1 = bf_hi(kp1[jj]), b0 = bf_lo(kp2[jj]), b1 = bf_hi(kp2[jj]);
            o1[jj] = cvt_pk_bf16(a0 * cs.x - b0 * cs.y, a1 * cs.z - b1 * cs.w);
            o2[jj] = cvt_pk_bf16(a0 * cs.y + b0 * cs.x, a1 * cs.w + b1 * cs.z);
        }
        *(LAS u32x4*)(Kb + prow * DIL_KS + 16 * pc) = o1;
        *(LAS u32x4*)(Kb + prow * DIL_KS + 32 + 16 * pc) = o2;
    }
    {
        const u32x4 mine = __builtin_bit_cast(u32x4, qf[0]);
        u32x4 oth, res;
#pragma unroll
        for (int jj = 0; jj < 4; ++jj) oth[jj] = (unsigned)__shfl_xor((int)mine[jj], 32);
#pragma unroll
        for (int jj = 0; jj < 4; ++jj) {
            const float4 cs = qcs[jj];
            const float m0 = bf_lo(mine[jj]), m1 = bf_hi(mine[jj]), o0 = bf_lo(oth[jj]), o1 = bf_hi(oth[jj]);
            float r0, r1;
            if (quad < 2) { r0 = m0 * cs.x - o0 * cs.y; r1 = m1 * cs.z - o1 * cs.w; }
            else          { r0 = o0 * cs.y + m0 * cs.x; r1 = o1 * cs.w + m1 * cs.z; }
            res[jj] = cvt_pk_bf16(r0, r1);
        }
        qf[0] = __builtin_bit_cast(bf16x8, res);
    }
}

DI void dil_compute(ldsp lds, const bf16x8 (&qf)[4], bf16_t* og, float* lse, int item, int wid, int lane) {
    const DilItem d = dil_decode(item);
    constexpr int KS = DIL_KS;
    const ldsp Kb = lds, Vb = lds + 256 * KS;
    const int li = lane & 15, quad = lane >> 4;
    const int qr = 16 * wid + li, tq = (128 * d.jb + qr) * d.r + d.ph;
    const int s_k0 = d.s_k0;
    const int kt0 = wid >> 1;
    const int kt_lo = (d.jb == 0) ? (4 - kt0) : 0;
    f32x4 sacc[10];
    if (kt_lo == 0) {
        bf16x8 kf[2][4];
        const ldsp ka0 = Kb + (32 * kt0 + li) * KS + quad * 16;
#pragma unroll
        for (int ks = 0; ks < 4; ++ks) kf[0][ks] = lds_rd8(ka0 + ks * 64);
#pragma unroll
        for (int t = 0; t < 10; ++t) {
            if (t + 1 < 10) {
#pragma unroll
                for (int ks = 0; ks < 4; ++ks) kf[(t + 1) & 1][ks] = lds_rd8(ka0 + (t + 1) * 16 * KS + ks * 64);
            }
            __builtin_amdgcn_sched_barrier(0);
            sacc[t] = (f32x4){0.f, 0.f, 0.f, 0.f};
#pragma unroll
            for (int ks = 0; ks < 4; ++ks) sacc[t] = mfma16(kf[t & 1][ks], qf[ks], sacc[t]);
            __builtin_amdgcn_sched_barrier(0);
        }
    } else {
#pragma unroll
        for (int t = 0; t < 10; ++t) {
            sacc[t] = (f32x4){0.f, 0.f, 0.f, 0.f};
            if ((t >> 1) < kt_lo) continue;
            const ldsp ka = Kb + (32 * kt0 + 16 * t + li) * KS + quad * 16;
#pragma unroll
            for (int ks = 0; ks < 4; ++ks) sacc[t] = mfma16(lds_rd8(ka + ks * 64), qf[ks], sacc[t]);
        }
    }
    const float scale = 0.08838834764831845f;
    float mx = -INFINITY;
#pragma unroll
    for (int t = 0; t < 10; ++t)
#pragma unroll
        for (int j = 0; j < 4; ++j) {
            const int kr = 32 * kt0 + 16 * t + quad * 4 + j, dist = qr + 128 - kr;
            const bool valid = (dist >= 0) && (dist <= 128) && (s_k0 + kr >= 0);
            const float v = valid ? sacc[t][j] * scale : -INFINITY;
            sacc[t][j] = v; mx = fmaxf(mx, v);
        }
    mx = fmaxf(mx, __shfl_xor(mx, 16)); mx = fmaxf(mx, __shfl_xor(mx, 32));
    float den = 0.f;
#pragma unroll
    for (int t = 0; t < 10; ++t)
#pragma unroll
        for (int j = 0; j < 4; ++j) { const float pv = exp2f((sacc[t][j] - mx) * 1.4426950408889634f); sacc[t][j] = pv; den += pv; }
    den += __shfl_xor(den, 16); den += __shfl_xor(den, 32);
    f32x4 oacc[8];
#pragma unroll
    for (int dt = 0; dt < 8; ++dt) oacc[dt] = (f32x4){0.f, 0.f, 0.f, 0.f};
    if (kt_lo == 0) {
        bf16x8 vfr[2][8];
        const ldsp va0 = Vb + (32 * kt0 + quad * 4 + (li >> 2)) * KS + (li & 3) * 8;
#pragma unroll
        for (int dt = 0; dt < 8; ++dt) vfr[0][dt] = lds_tr8(va0 + dt * 32, va0 + 16 * KS + dt * 32);
#pragma unroll
        for (int kt = 0; kt < 5; ++kt) {
            if (kt + 1 < 5) {
#pragma unroll
                for (int dt = 0; dt < 8; ++dt) vfr[(kt + 1) & 1][dt] = lds_tr8(va0 + (kt + 1) * 32 * KS + dt * 32, va0 + (kt + 1) * 32 * KS + 16 * KS + dt * 32);
            }
            u32x4 pw; pw.x = cvt_pk_bf16(sacc[2 * kt][0], sacc[2 * kt][1]); pw.y = cvt_pk_bf16(sacc[2 * kt][2], sacc[2 * kt][3]);
            pw.z = cvt_pk_bf16(sacc[2 * kt + 1][0], sacc[2 * kt + 1][1]); pw.w = cvt_pk_bf16(sacc[2 * kt + 1][2], sacc[2 * kt + 1][3]);
            const bf16x8 pf = __builtin_bit_cast(bf16x8, pw);
            __builtin_amdgcn_sched_barrier(0);
#pragma unroll
            for (int dt = 0; dt < 8; ++dt) oacc[dt] = mfma16(vfr[kt & 1][dt], pf, oacc[dt]);
            __builtin_amdgcn_sched_barrier(0);
        }
    } else {
#pragma unroll
        for (int kt = 0; kt < 5; ++kt) {
            if (kt < kt_lo) continue;
            u32x4 pw; pw.x = cvt_pk_bf16(sacc[2 * kt][0], sacc[2 * kt][1]); pw.y = cvt_pk_bf16(sacc[2 * kt][2], sacc[2 * kt][3]);
            pw.z = cvt_pk_bf16(sacc[2 * kt + 1][0], sacc[2 * kt + 1][1]); pw.w = cvt_pk_bf16(sacc[2 * kt + 1][2], sacc[2 * kt + 1][3]);
            const bf16x8 pf = __builtin_bit_cast(bf16x8, pw);
            const ldsp va = Vb + (32 * (kt0 + kt) + quad * 4 + (li >> 2)) * KS + (li & 3) * 8;
#pragma unroll
            for (int dt = 0; dt < 8; ++dt) oacc[dt] = mfma16(lds_tr8(va + dt * 32, va + 16 * KS + dt * 32), pf, oacc[dt]);
        }
    }
    const float inv = 1.0f / den;
    bf16_t* dst = og + (d.rowbase + tq) * 2304 + d.g * 768 + d.head * 128 + quad * 4;
#pragma unroll
    for (int dt = 0; dt < 8; ++dt) { u32x2 o; o.x = cvt_pk_bf16(oacc[dt][0] * inv, oacc[dt][1] * inv); o.y = cvt_pk_bf16(oacc[dt][2] * inv, oacc[dt][3] * inv); *(u32x2*)(dst + dt * 16) = o; }
    if (quad == 0) lse[(d.rowbase + tq) * 18 + d.g * 6 + d.head] = mx + __logf(den);
}

struct DilPrev { const bf16_t* og; const float* lse; const bf16_t* proj; bf16_t* br; int b0; };
DI void dil_combine(const bf16_t* og, const float* lse, const bf16_t* proj, bf16_t* br, int b0, int u0, int u1, int ustride);
DI void dil_attn_phase(ldsp lds, const bf16_t* proj, bf16_t* og, float* lse, const float* rope, int nitems, const DilPrev pv, int tid_, int wid_, int lane_) {
    DilPre P;
    int it = blockIdx.x;
    if (it < nitems) dil_load(P, proj, it, tid_, wid_, lane_);
    for (; it < nitems; it += gridDim.x) {
        int tid = tid_; asm volatile("" : "+v"(tid));
        const int wid = __builtin_amdgcn_readfirstlane(tid >> 6), lane = tid & 63;
        bf16x8 qf[4];
        dil_store(P, qf, lds, proj, rope, it, tid, wid, lane);
        __syncthreads();
        if (it + (int)gridDim.x < nitems) dil_load(P, proj, it + gridDim.x, tid, wid, lane);
        dil_compute(lds, qf, og, lse, it, wid, lane);
        if (pv.og) {
            constexpr int PIECE = (SLAB_ROWS * 96 + SLAB_B * 288 - 1) / (SLAB_B * 288);
            const int u0 = it * PIECE, u1 = (u0 + PIECE < SLAB_ROWS * 96) ? u0 + PIECE : SLAB_ROWS * 96;
            dil_combine(pv.og, pv.lse, pv.proj, pv.br, pv.b0, u0 + tid, u1, NTHREADS);
        }
        __syncthreads();
    }
}

DI void mem_attn_item(ldsp lds, const bf16_t* proj, int ldp, int qmcol, int gatecol, const bf16_t* kv, bf16_t* branch, int b0, int item, int tid, int wid, int lane, const bool stage = true) {
    const int qt = item & 15, hm = (item >> 4) & 3, bl = item >> 6;
    constexpr int KS = 144;
    const ldsp Kb = lds, Vb = lds + 256 * KS;
    const bf16_t* kvb = kv + (size_t)(b0 + bl) * 256 * 2048 + hm * 64;
    if (stage) {
        u32x4 kx[4], vx[4];
#pragma unroll
        for (int i = 0; i < 4; ++i) {
            const int e = tid + i * 512, row = e >> 3, ch = e & 7;
            kx[i] = *(const u32x4*)(kvb + (size_t)row * 2048 + ch * 8);
            vx[i] = *(const u32x4*)(kvb + (size_t)row * 2048 + 256 + ch * 8);
        }
#pragma unroll
        for (int i = 0; i < 4; ++i) {
            const int e = tid + i * 512, row = e >> 3, ch = e & 7;
            *(LAS u32x4*)(Kb + row * KS + ch * 16) = kx[i];
            *(LAS u32x4*)(Vb + row * KS + ch * 16) = vx[i];
        }
    }
    const int li = lane & 15, quad = lane >> 4;
    const int tq = 128 * qt + 16 * wid + li;
    const size_t prow = (size_t)bl * 2048 + tq;
    bf16x8 qf[2];
#pragma unroll
    for (int ks = 0; ks < 2; ++ks) qf[ks] = *(const bf16x8*)(proj + prow * ldp + qmcol + hm * 64 + ks * 32 + quad * 8);
    u32x2 gtv[4];
#pragma unroll
    for (int dt = 0; dt < 4; ++dt) gtv[dt] = *(const u32x2*)(proj + prow * ldp + gatecol + 768 + hm * 64 + quad * 4 + dt * 16);
    __syncthreads();
    f32x4 sacc[16];
#pragma unroll
    for (int t = 0; t < 16; ++t) {
        sacc[t] = (f32x4){0.f, 0.f, 0.f, 0.f};
        const ldsp ka = Kb + (16 * t + li) * KS + quad * 16;
#pragma unroll
        for (int ks = 0; ks < 2; ++ks) sacc[t] = mfma16(lds_rd8(ka + ks * 64), qf[ks], sacc[t]);
    }
    float mx = -INFINITY;
#pragma unroll
    for (int t = 0; t < 16; ++t)
#pragma unroll
        for (int j = 0; j < 4; ++j) { const float v = sacc[t][j] * 0.125f; sacc[t][j] = v; mx = fmaxf(mx, v); }
    mx = fmaxf(mx, __shfl_xor(mx, 16)); mx = fmaxf(mx, __shfl_xor(mx, 32));
    float den = 0.f;
#pragma unroll
    for (int t = 0; t < 16; ++t)
#pragma unroll
        for (int j = 0; j < 4; ++j) { const float pv = exp2f((sacc[t][j] - mx) * 1.4426950408889634f); sacc[t][j] = pv; den += pv; }
    den += __shfl_xor(den, 16); den += __shfl_xor(den, 32);
    f32x4 oacc[4];
#pragma unroll
    for (int dt = 0; dt < 4; ++dt) oacc[dt] = (f32x4){0.f, 0.f, 0.f, 0.f};
#pragma unroll
    for (int kt = 0; kt < 8; ++kt) {
        u32x4 pw; pw.x = cvt_pk_bf16(sacc[2 * kt][0], sacc[2 * kt][1]); pw.y = cvt_pk_bf16(sacc[2 * kt][2], sacc[2 * kt][3]);
        pw.z = cvt_pk_bf16(sacc[2 * kt + 1][0], sacc[2 * kt + 1][1]); pw.w = cvt_pk_bf16(sacc[2 * kt + 1][2], sacc[2 * kt + 1][3]);
        const bf16x8 pf = __builtin_bit_cast(bf16x8, pw);
        const ldsp va = Vb + (32 * kt + quad * 4 + (li >> 2)) * KS + (li & 3) * 8;
#pragma unroll
        for (int dt = 0; dt < 4; ++dt) oacc[dt] = mfma16(lds_tr8(va + dt * 32, va + 16 * KS + dt * 32), pf, oacc[dt]);
    }
    const float inv = 1.0f / den;
    bf16_t* dst = branch + ((size_t)(b0 + bl) * 2048 + tq) * 1024 + 768 + hm * 64 + quad * 4;
#pragma unroll
    for (int dt = 0; dt < 4; ++dt) {
        const u32x2 gt = gtv[dt];
        u32x2 o;
        o.x = cvt_pk_bf16(oacc[dt][0] * inv * silu_f(bf_lo(gt.x)), oacc[dt][1] * inv * silu_f(bf_hi(gt.x)));
        o.y = cvt_pk_bf16(oacc[dt][2] * inv * silu_f(bf_lo(gt.y)), oacc[dt][3] * inv * silu_f(bf_hi(gt.y)));
        *(u32x2*)(dst + dt * 16) = o;
    }
    __syncthreads();
}

DI void gla_item(ldsp lds, const Params& p, const bf16_t* proj, bf16_t* obuf, const float* q0k0, int jl, int item, int tid, int wid, int lane) {
    const int half = item & 1, h = (item >> 1) & 3, b = item >> 3;
    constexpr int O_GL = 0, O_WG = 5120, O_BG = 12800, O_LA = 13312, O_QI = 38912, O_KI = 52224, O_KO = 65536, O_V = 78848, O_AM = 92160, O_ST = 101376;
    constexpr int S96 = 208, SGL = 80, SAM = 144, SLA = 100;
    const ldsp GL = lds + O_GL, WG = lds + O_WG, QI = lds + O_QI, KI = lds + O_KI, KO = lds + O_KO, Vl = lds + O_V, AM = lds + O_AM, ST = lds + O_ST;
    LAS float* BG = (LAS float*)(lds + O_BG);
    LAS float* LA = (LAS float*)(lds + O_LA);
    const int li = lane & 15, quad = lane >> 4;
    {
        float wv6[6];
#pragma unroll
        for (int i = 0; i < 6; ++i) { const int e = tid + i * 512, d = e >> 5, kk = e & 31;
            wv6[i] = kk < 16 ? p.w_gate_up[(size_t)(jl * 16 + kk) * 384 + h * 96 + d] : 0.f; }
#pragma unroll
        for (int i = 0; i < 6; ++i) { const int e = tid + i * 512, d = e >> 5, kk = e & 31; *(LAS bf16_t*)(WG + d * SGL + kk * 2) = f2bf(wv6[i]); }
    }
    for (int e = tid; e < 64 * 40; e += 512) *(LAS bf16_t*)(GL + e * 2) = 0;
    if (tid < 96) BG[tid] = p.b_gate[jl * 384 + h * 96 + tid];
    float a00;
    {
        const float* qp = q0k0 + b * 768 + h * 96; const float* kp = qp + 384;
        float t = qp[lane] * kp[lane] + (lane < 32 ? qp[64 + lane] * kp[64 + lane] : 0.f);
        a00 = wave_sum(t) * 0.10206207261596575f;
    }
    f32x4 S[6];
#pragma unroll
    for (int i = 0; i < 6; ++i) S[i] = (f32x4){0.f, 0.f, 0.f, 0.f};
    __syncthreads();
    const int c0 = tid, c1 = tid + 512;
    const int row0 = c0 / 12, ch0 = c0 - row0 * 12, row1 = c1 / 12, ch1 = c1 - row1 * 12;
    const bool has1 = tid < 256;
    u32x4 qreg0, kreg0, vreg0, qreg1 = (u32x4){0u, 0u, 0u, 0u}, kreg1 = qreg1, vreg1 = qreg1, greg = qreg1;
#define GLA_LOAD_CHUNK(nn) do { const size_t rb_ = (size_t)b * 2048 + (nn) * 64; \
        const bf16_t* r0p = proj + (rb_ + row0) * GLA_NP; \
        qreg0 = *(const u32x4*)(r0p + h * 96 + ch0 * 8); kreg0 = *(const u32x4*)(r0p + GA_K + h * 96 + ch0 * 8); \
        vreg0 = *(const u32x4*)(r0p + GA_V + h * 192 + half * 96 + ch0 * 8); \
        if (has1) { const bf16_t* r1p = proj + (rb_ + row1) * GLA_NP; \
            qreg1 = *(const u32x4*)(r1p + h * 96 + ch1 * 8); kreg1 = *(const u32x4*)(r1p + GA_K + h * 96 + ch1 * 8); \
            vreg1 = *(const u32x4*)(r1p + GA_V + h * 192 + half * 96 + ch1 * 8); } \
        if (tid < 128) greg = *(const u32x4*)(proj + (rb_ + (tid >> 1)) * GLA_NP + GA_GL + (tid & 1) * 8); } while (0)
    GLA_LOAD_CHUNK(0);
    for (int n = 0; n < 32; ++n) {
        const size_t rowb = (size_t)b * 2048 + n * 64;
        *(LAS u32x4*)(Vl + row0 * S96 + ch0 * 16) = vreg0;
        if (has1) *(LAS u32x4*)(Vl + row1 * S96 + ch1 * 16) = vreg1;
        if (tid < 128) *(LAS u32x4*)(GL + (tid >> 1) * SGL + (tid & 1) * 16) = greg;
        __syncthreads();
        if (wid < 6) {
            const int d = 16 * wid + li; const float bias = BG[d];
            const bf16x8 bb = lds_rd8(WG + (16 * wid + li) * SGL + quad * 16);
            float base = 0.f;
#pragma unroll
            for (int it = 0; it < 4; ++it) {
                const bf16x8 a = lds_rd8(GL + (16 * it + li) * SGL + quad * 16);
                const f32x4 c = mfma16(a, bb, (f32x4){0.f, 0.f, 0.f, 0.f});
                const float c0 = logsig_f(c[0] + bias) * (1.0f / 16.0f);
                const float c1 = c0 + logsig_f(c[1] + bias) * (1.0f / 16.0f);
                const float c2 = c1 + logsig_f(c[2] + bias) * (1.0f / 16.0f);
                const float c3 = c2 + logsig_f(c[3] + bias) * (1.0f / 16.0f);
                float sc = c3;
                float t = __shfl_up(sc, 16); if (quad >= 1) sc += t;
                t = __shfl_up(sc, 32); if (quad >= 2) sc += t;
                const float tot = __shfl(sc, 48 + li);
                const float o = base + (sc - c3);
                LAS float* lp = LA + (16 * it + quad * 4) * SLA + d;
                lp[0] = o + c0; lp[SLA] = o + c1; lp[2 * SLA] = o + c2; lp[3 * SLA] = o + c3;
                base += tot;
            }
#pragma unroll
            for (int dt = 0; dt < 6; ++dt) { u32x2 w; w.x = cvt_pk_bf16(S[dt][0], S[dt][1]); w.y = cvt_pk_bf16(S[dt][2], S[dt][3]);
                *(LAS u32x2*)(ST + (16 * wid + li) * S96 + (16 * dt + quad * 4) * 2) = w; }
        }
        __syncthreads();
#pragma unroll
        for (int cc = 0; cc < 2; ++cc) {
            if (cc == 1 && !has1) break;
            const int row = cc ? row1 : row0, ch = cc ? ch1 : ch0;
            const u32x4 qv = cc ? qreg1 : qreg0, kv = cc ? kreg1 : kreg0;
            const f32x4 b0v = *(LAS f32x4*)(LA + row * SLA + ch * 8), b1v = *(LAS f32x4*)(LA + row * SLA + ch * 8 + 4);
            const f32x4 l0v = *(LAS f32x4*)(LA + 63 * SLA + ch * 8), l1v = *(LAS f32x4*)(LA + 63 * SLA + ch * 8 + 4);
            u32x4 qi, ki, ko;
#pragma unroll
            for (int e2 = 0; e2 < 4; ++e2) {
                const float bA = e2 < 2 ? b0v[2 * e2] : b1v[2 * e2 - 4], bB = e2 < 2 ? b0v[2 * e2 + 1] : b1v[2 * e2 - 3];
                const float lA = e2 < 2 ? l0v[2 * e2] : l1v[2 * e2 - 4], lB = e2 < 2 ? l0v[2 * e2 + 1] : l1v[2 * e2 - 3];
                const float qa = bf_lo(qv[e2]), qb = bf_hi(qv[e2]), ka = bf_lo(kv[e2]), kb = bf_hi(kv[e2]);
                qi[e2] = cvt_pk_bf16(qa * 0.10206207261596575f * __expf(bA), qb * 0.10206207261596575f * __expf(bB));
                ki[e2] = cvt_pk_bf16(ka * __expf(-bA), kb * __expf(-bB));
                ko[e2] = cvt_pk_bf16(ka * __expf(lA - bA), kb * __expf(lB - bB));
            }
            *(LAS u32x4*)(QI + row * S96 + ch * 16) = qi;
            *(LAS u32x4*)(KI + row * S96 + ch * 16) = ki;
            *(LAS u32x4*)(KO + row * S96 + ch * 16) = ko;
        }
        if (n + 1 < 32) GLA_LOAD_CHUNK(n + 1);
        __syncthreads();
#pragma unroll
        for (int i = 0; i < 2; ++i) {
            const int tile = wid + 8 * i, ti = tile >> 2, tj = tile & 3;
            u32x2 w = (u32x2){0u, 0u};
            if (tj <= ti) {
                f32x4 c = (f32x4){0.f, 0.f, 0.f, 0.f};
#pragma unroll
                for (int ks = 0; ks < 3; ++ks) c = mfma16(lds_rd8(KI + (16 * tj + li) * S96 + (ks * 32 + quad * 8) * 2), lds_rd8(QI + (16 * ti + li) * S96 + (ks * 32 + quad * 8) * 2), c);
                const int ii = 16 * ti + li, j0 = 16 * tj + quad * 4;
                if (n == 0 && tile == 0 && li == 0 && quad == 0) c[0] = a00;
                w.x = cvt_pk_bf16(j0 <= ii ? c[0] : 0.f, j0 + 1 <= ii ? c[1] : 0.f);
                w.y = cvt_pk_bf16(j0 + 2 <= ii ? c[2] : 0.f, j0 + 3 <= ii ? c[3] : 0.f);
            }
            *(LAS u32x2*)(AM + (16 * ti + li) * SAM + (16 * tj + quad * 4) * 2) = w;
        }
        __syncthreads();
        if (wid < 6) {
            const int e0 = 16 * wid;
            bf16x8 vf[2];
#pragma unroll
            for (int ks = 0; ks < 2; ++ks) { const ldsp a0 = Vl + (32 * ks + quad * 8 + (li >> 2)) * S96 + (e0 + 4 * (li & 3)) * 2; vf[ks] = lds_tr8(a0, a0 + 4 * S96); }
            f32x4 o[4];
#pragma unroll
            for (int ti = 0; ti < 4; ++ti) { o[ti] = (f32x4){0.f, 0.f, 0.f, 0.f};
#pragma unroll
                for (int ks = 0; ks < 2; ++ks) if (2 * ks <= ti) o[ti] = mfma16(vf[ks], lds_rd8(AM + (16 * ti + li) * SAM + (32 * ks + quad * 8) * 2), o[ti]); }
#pragma unroll
            for (int ks = 0; ks < 3; ++ks) { const bf16x8 a = lds_rd8(ST + (e0 + li) * S96 + (32 * ks + quad * 8) * 2);
#pragma unroll
                for (int ti = 0; ti < 4; ++ti) o[ti] = mfma16(a, lds_rd8(QI + (16 * ti + li) * S96 + (32 * ks + quad * 8) * 2), o[ti]); }
#pragma unroll
            for (int ti = 0; ti < 4; ++ti) { u32x2 w; w.x = cvt_pk_bf16(o[ti][0], o[ti][1]); w.y = cvt_pk_bf16(o[ti][2], o[ti][3]);
                *(u32x2*)(obuf + (rowb + 16 * ti + li) * 768 + h * 192 + half * 96 + e0 + quad * 4) = w; }
#pragma unroll
            for (int dt = 0; dt < 6; ++dt) {
                const f32x4 lb = *(LAS f32x4*)(LA + 63 * SLA + 16 * dt + quad * 4);
#pragma unroll
                for (int jj = 0; jj < 4; ++jj) S[dt][jj] *= __expf(lb[jj]);
#pragma unroll
                for (int ks = 0; ks < 2; ++ks) { const ldsp a0 = KO + (32 * ks + quad * 8 + (li >> 2)) * S96 + (16 * dt + 4 * (li & 3)) * 2; S[dt] = mfma16(lds_tr8(a0, a0 + 4 * S96), vf[ks], S[dt]); }
            }
        }
        __syncthreads();
    }
}

#undef GLA_LOAD_CHUNK
DI void dil_combine(const bf16_t* og, const float* lse, const bf16_t* proj, bf16_t* br, int b0, int u0, int u1, int ustride) {
    for (int u = u0; u < u1; u += ustride) {
        const int row = u / 96, ch = u - row * 96, head = ch >> 4;
        const float l0 = lse[(size_t)row * 18 + head], l1 = lse[(size_t)row * 18 + 6 + head], l2 = lse[(size_t)row * 18 + 12 + head];
        const float m = fmaxf(l0, fmaxf(l1, l2));
        float e0 = __expf(l0 - m), e1 = __expf(l1 - m), e2 = __expf(l2 - m);
        const float is = 1.0f / (e0 + e1 + e2); e0 *= is; e1 *= is; e2 *= is;
        const bf16_t* ob = og + (size_t)row * 2304 + ch * 8;
        const u32x4 a = *(const u32x4*)ob, bq = *(const u32x4*)(ob + 768), c = *(const u32x4*)(ob + 1536);
        const u32x4 gv = *(const u32x4*)(proj + (size_t)row * DIL_N + DB_GATE + ch * 8);
        u32x4 w;
#pragma unroll
        for (int e = 0; e < 4; ++e) {
            const float vlo = e0 * bf_lo(a[e]) + e1 * bf_lo(bq[e]) + e2 * bf_lo(c[e]);
            const float vhi = e0 * bf_hi(a[e]) + e1 * bf_hi(bq[e]) + e2 * bf_hi(c[e]);
            w[e] = cvt_pk_bf16(vlo * silu_f(bf_lo(gv[e])), vhi * silu_f(bf_hi(gv[e])));
        }
        *(u32x4*)(br + ((size_t)b0 * SEQ + row) * 1024 + ch * 8) = w;
    }
}
__global__ void __launch_bounds__(NTHREADS, 2) megak(Params p) {
    extern __shared__ __attribute__((aligned(16))) unsigned char shm[];
    const ldsp lds = (ldsp)shm;
    cg::grid_group grid = cg::this_grid();
    unsigned char* ws = p.ws;
    bf16_t* WA = (bf16_t*)(ws + WS_WA); bf16_t* WB = (bf16_t*)(ws + WS_WB); bf16_t* WO = (bf16_t*)(ws + WS_WO); bf16_t* WKV = (bf16_t*)(ws + WS_WKV);
    bf16_t* MEMN = (bf16_t*)(ws + WS_MEMN); bf16_t* KV = (bf16_t*)(ws + WS_KV); float* ROPE = (float*)(ws + WS_ROPE);
    bf16_t* H = (bf16_t*)((unsigned char*)p.out + DO_H); bf16_t* PROJ = (bf16_t*)(ws + WS_PROJ); bf16_t* OBUF = (bf16_t*)(ws + WS_OBUF); bf16_t* OBUF2 = (bf16_t*)((unsigned char*)p.out + DO_OBUF2);
    float* LSE = (float*)(ws + WS_LSE); bf16_t* BR = (bf16_t*)(ws + WS_BR); float* SS = (float*)(ws + WS_SS); float* Q0K0 = (float*)(ws + WS_Q0);
    float* T0P = (float*)(ws + WS_T0P); float* T0BR = (float*)(ws + WS_T0BR); float* T0X1 = (float*)(ws + WS_T0X1); float* T0X2 = (float*)(ws + WS_T0X2); bf16_t* XB = (bf16_t*)(ws + WS_XB);
    volatile LAS unsigned* bst = (volatile LAS unsigned*)(lds + LDS_WORK);
    if (threadIdx.x == 0) { bst[0] = 0u; bst[1] = 0u; }
    __syncthreads();
    const XcdBarrier xb = xcd_barrier_post((unsigned*)(ws + WS_BAR), bst);
    for (int s = p.ph_lo; s < p.ph_hi; ++s) {
        int tid = threadIdx.x;
        const Step st = decode_step(s);
        const int L = st.layer, jl = L >> 1; const bool gla = (L & 1) == 0;
        int nrep = 1;
        if (st.type == T_G1) nrep = REP_G1;
        if (st.type == T_MIX) nrep = gla ? REP_MIXA : REP_MIXB;
        if (st.type == T_BR) nrep = REP_BR;
        for (int rep = 0; rep < nrep; ++rep) {
        if (rep) xcd_barrier(xb);
        asm volatile("" : "+v"(tid));
        const int wid = __builtin_amdgcn_readfirstlane(tid >> 6), lane = tid & 63;
        const int gtid = blockIdx.x * NTHREADS + tid, gthreads = gridDim.x * NTHREADS;
        switch (st.type) {
        case T_PRO: {
            for (int j = 0; j < 2; ++j) transpose_w(lds, p.w_in_a + (size_t)j * 1024 * GLA_N, GLA_N, GLA_NP, WA + (size_t)j * GLA_NP * 1024, tid);
            for (int j = 0; j < 2; ++j) transpose_w(lds, p.w_in_b + (size_t)j * 1024 * DIL_N, DIL_N, DIL_N, WB + (size_t)j * DIL_N * 1024, tid);
            for (int j = 0; j < 4; ++j) transpose_w(lds, p.w_out + (size_t)j * 1024 * 1024, 1024, 1024, WO + (size_t)j * 1024 * 1024, tid);
            for (int j = 0; j < 4; ++j) transpose_w(lds, p.w_memkv + (size_t)j * 1024 * 512, 512, 512, WKV + (size_t)j * 512 * 1024, tid);
            norm_rows<true>(p.mem, p.mem_norm_w, MEMN, BATCH * 256, wid, lane);
            for (int e = gtid; e < 2048 * 16; e += gthreads) {
                const int pos = e >> 4, i = e & 15;
                const float inv = exp2f(-(float)i * 1.1832230355827609f);
                const float ang = (float)pos * inv;
                const double a = (double)ang;
                const double k = rint(a * 0.15915494309189535);
                const float rf = (float)(a - k * 6.283185307179586);
                ROPE[2 * e] = __cosf(rf); ROPE[2 * e + 1] = __sinf(rf);
            }
        } break;
        case T_KV: {
            pg8::Gemm g{MEMN, WKV, BATCH * 256, 2048, 1024};
            pg8::StaticOrder so; so.init(g.M, g.N, (int)gridDim.x, (int)blockIdx.x);
            pg8::EpiBf ep{KV, 2048};
            pg8::gemm_phase<pg8::EpiBf, pg8::StaticOrder>(lds, g, so, ep, tid);
            norm_rows<true>(p.x, p.norm_w, H, MTOK, wid, lane);
            __syncthreads();
            for (int t = blockIdx.x; t < 89; t += gridDim.x)
                tok0_gemv(lds, p.x, (size_t)SEQ * 1024, p.norm_w, p.w_in_a, GLA_N, T0P, 8192, nullptr, 0, t, tid, wid, lane);
        } break;
        case T_G1: {
            pg8::Gemm g; pg8::EpiBf ep;
            if (gla) { g = pg8::Gemm{H, WA + (size_t)jl * GLA_NP * 1024, MTOK, GLA_NP, 1024}; ep = pg8::EpiBf{PROJ, GLA_NP}; }
            else     { g = pg8::Gemm{H + (size_t)st.b0 * SEQ * 1024, WB + (size_t)jl * DIL_N * 1024, SLAB_ROWS, DIL_N, 1024}; ep = pg8::EpiBf{PROJ + ((st.b0 / SLAB_B) & 1) * PROJ_SLAB, DIL_N}; }
            pg8::StaticOrder so; so.init(g.M, g.N, (int)gridDim.x, (int)blockIdx.x);
            pg8::gemm_phase<pg8::EpiBf, pg8::StaticOrder>(lds, g, so, ep, tid);
            if (gla) {
                __syncthreads();
                for (int t = blockIdx.x; t < BATCH * 8; t += gridDim.x)
                    token0_task(lds, L == 0 ? p.x : T0X2, L == 0 ? (size_t)SEQ * 1024 : (size_t)1024, p.norm_w + L * 1024, p.w_in_a + (size_t)jl * 1024 * GLA_N, Q0K0, t, tid, wid, lane);
                if (L == 0) for (int t = blockIdx.x; t < BATCH * 4; t += gridDim.x) tok0_mix_gla(lds, p, T0P, T0BR, t, tid, wid, lane);
            } else if (L == 1 && st.b0 == 0) {
                __syncthreads();
                for (int t = blockIdx.x; t < 32; t += gridDim.x)
                    tok0_gemv(lds, T0BR, 1024, nullptr, p.w_out + (size_t)1024 * 1024, 1024, T0X2, 1024, T0X1, 1024, t, tid, wid, lane);
            }
        } break;
        case T_MIX: {
            const bf16_t* kvl = KV + L * 512;
            if (gla) {
                for (int it = blockIdx.x; it < BATCH * 8; it += gridDim.x) gla_item(lds, p, PROJ, OBUF, Q0K0, jl, it, tid, wid, lane);
                if (gridDim.x == 256) {
                    const int grp = blockIdx.x >> 1;
                    for (int j = 0; j < 8; ++j) mem_attn_item(lds, PROJ, GLA_NP, GA_QM, GA_GATE, kvl, BR, 0, ((blockIdx.x & 1) * 8 + j) + 16 * grp, tid, wid, lane, j == 0);
                } else
                for (int it = blockIdx.x; it < BATCH * 64; it += gridDim.x) mem_attn_item(lds, PROJ, GLA_NP, GA_QM, GA_GATE, kvl, BR, 0, it, tid, wid, lane);
                if (L == 0) for (int t = blockIdx.x; t < 32; t += gridDim.x)
                    tok0_gemv(lds, T0BR, 1024, nullptr, p.w_out, 1024, T0X1, 1024, p.x, (size_t)SEQ * 1024, t, tid, wid, lane);
            } else {
                const int sl = st.b0 / SLAB_B, par = sl & 1;
                const bf16_t* PJ = PROJ + par * PROJ_SLAB;
                DilPrev pv{nullptr, nullptr, nullptr, nullptr, 0};
                if (sl > 0) pv = DilPrev{par ? OBUF : OBUF2, LSE + (par ^ 1) * LSE_SLAB, PROJ + (par ^ 1) * PROJ_SLAB, BR, st.b0 - SLAB_B};
                dil_attn_phase(lds, PJ, par ? OBUF2 : OBUF, LSE + par * LSE_SLAB, ROPE, SLAB_B * 288, pv, tid, wid, lane);
                if (gridDim.x == 256) {
                    const int grp = blockIdx.x >> 3;
                    for (int j = 0; j < 2; ++j) mem_attn_item(lds, PJ, DIL_N, DB_QM, DB_GATE, kvl, BR, st.b0, ((blockIdx.x & 7) * 2 + j) + 16 * grp, tid, wid, lane, j == 0);
                } else
                for (int it = blockIdx.x; it < SLAB_B * 64; it += gridDim.x) mem_attn_item(lds, PJ, DIL_N, DB_QM, DB_GATE, kvl, BR, st.b0, it, tid, wid, lane);
            }
        } break;
        case T_BR: {
            if (gla) {
                const int l32 = lane & 31; const bool act = l32 < 24;
                const int hw0 = (blockIdx.x * 8 + wid) * 2 + (lane >> 5), nhw = gridDim.x * 16;
                f32x4 g0 = (f32x4){0.f, 0.f, 0.f, 0.f}, g1 = g0;
                if (act) { g0 = *(const f32x4*)(p.gla_norm_w + jl * 192 + l32 * 8); g1 = *(const f32x4*)(p.gla_norm_w + jl * 192 + l32 * 8 + 4); }
                for (int ub = hw0; ub < MTOK * 4; ub += 4 * nhw) {
                    u32x4 ovq[4], gvq[4];
#pragma unroll
                    for (int q = 0; q < 4; ++q) {
                        const int u = ub + q * nhw, uu = u < MTOK * 4 ? u : ub, tok = uu >> 2, hh = uu & 3;
                        ovq[q] = (u32x4){0u, 0u, 0u, 0u}; gvq[q] = ovq[q];
                        if (act) { ovq[q] = *(const u32x4*)(OBUF + (size_t)tok * 768 + hh * 192 + l32 * 8); gvq[q] = *(const u32x4*)(PROJ + (size_t)tok * GLA_NP + GA_GATE + hh * 192 + l32 * 8); }
                    }
#pragma unroll
                    for (int q = 0; q < 4; ++q) {
                        const int u = ub + q * nhw, tok = u >> 2, hh = u & 3;
                        float o[8], gt[8];
#pragma unroll
                        for (int e = 0; e < 4; ++e) { o[2 * e] = bf_lo(ovq[q][e]); o[2 * e + 1] = bf_hi(ovq[q][e]); gt[2 * e] = bf_lo(gvq[q][e]); gt[2 * e + 1] = bf_hi(gvq[q][e]); }
                        float ss = 0.f;
#pragma unroll
                        for (int e = 0; e < 8; ++e) ss += o[e] * o[e];
#pragma unroll
                        for (int m = 16; m; m >>= 1) ss += __shfl_xor(ss, m);
                        const float rs = rsqrtf(ss * (1.0f / 192.0f) + 1e-6f);
                        if (act && u < MTOK * 4) {
                            u32x4 w;
#pragma unroll
                            for (int e = 0; e < 4; ++e) {
                                const float wa = e < 2 ? g0[2 * e] : g1[2 * e - 4], wb = e < 2 ? g0[2 * e + 1] : g1[2 * e - 3];
                                w[e] = cvt_pk_bf16(o[2 * e] * rs * wa * silu_f(gt[2 * e]), o[2 * e + 1] * rs * wb * silu_f(gt[2 * e + 1]));
                            }
                            *(u32x4*)(BR + (size_t)tok * 1024 + hh * 192 + l32 * 8) = w;
                        }
                    }
                }
                if (L == 0) for (int t = blockIdx.x; t < 256; t += gridDim.x)
                    tok0_gemv(lds, T0X1, 1024, p.norm_w + 1024, p.w_in_b, DIL_N, T0P, 8192, nullptr, 0, t, tid, wid, lane);
            } else {
                const int par = (st.b0 / SLAB_B) & 1;
                dil_combine(par ? OBUF2 : OBUF, LSE + par * LSE_SLAB, PROJ + par * PROJ_SLAB, BR, st.b0, gtid, SLAB_ROWS * 96, gthreads);
            }
        } break;
        case T_G2: {
            pg8::Gemm g{BR, WO + (size_t)L * 1024 * 1024, MTOK, 1024, 1024};
            pg8::StaticOrder so; so.init(g.M, g.N, (int)gridDim.x, (int)blockIdx.x);
            pg8::EpiRes ep{L == 0 ? p.x : nullptr, XB, XB};
            pg8::gemm_phase<pg8::EpiRes, pg8::StaticOrder>(lds, g, so, ep, tid);
            if (L == 0) {
                __syncthreads();
                for (int t = blockIdx.x; t < BATCH * 4; t += gridDim.x) tok0_mix_dil(lds, p, T0P, T0BR, t, tid, wid, lane);
            }
        } break;
        case T_NORM: {
            if (L < 3) norm_rows_bf<true>(XB, p.norm_w + (L + 1) * 1024, H, MTOK, lane, blockIdx.x * 8 + wid, gridDim.x * 8);
            else norm_rows_bf<false>(XB, p.final_norm_w, p.out, MTOK, lane, blockIdx.x * 8 + wid, gridDim.x * 8);
        } break;
        default: break;
        }
        }
        if (s + 1 < p.ph_hi) { if (p.ph_hi > 1000) grid.sync(); else xcd_barrier(xb); }
    }
}

extern "C" void kernel_launch(void* const* d_in, const int* in_sizes, int n_in, void* d_out, int out_size, void* d_ws, size_t ws_size, hipStream_t stream) {
    static int grid = 0;
    if (grid == 0) {
        if (n_in != 12 || in_sizes[0] != MTOK * DM || out_size != MTOK * DM || ws_size < WS_END) {
            fprintf(stderr, "kernel_launch: unexpected shapes / workspace (n_in %d in0 %d out %d ws %zu need %zu)\n", n_in, n_in > 0 ? in_sizes[0] : -1, out_size, ws_size, (size_t)WS_END);
            grid = -1; return;
        }
        int dev = 0, cus = 0, per_cu = 0;
        (void)hipGetDevice(&dev);
        (void)hipDeviceGetAttribute(&cus, hipDeviceAttributeMultiprocessorCount, dev);
        if (hipFuncSetAttribute((const void*)megak, hipFuncAttributeMaxDynamicSharedMemorySize, LDS_BYTES) != hipSuccess) { fprintf(stderr, "kernel_launch: hipFuncSetAttribute failed\n"); grid = -1; return; }
        if (hipOccupancyMaxActiveBlocksPerMultiprocessor(&per_cu, (const void*)megak, NTHREADS, LDS_BYTES) != hipSuccess || per_cu < 1) { fprintf(stderr, "kernel_launch: occupancy query gave %d\n", per_cu); per_cu = 1; }
        (void)hipGetLastError();
        grid = cus * per_cu;
    }
    if (grid < 0) return;
    Params p{};
    p.x = (const float*)d_in[0]; p.mem = (const float*)d_in[1]; p.mem_norm_w = (const float*)d_in[2]; p.norm_w = (const float*)d_in[3];
    p.w_memkv = (const float*)d_in[4]; p.w_out = (const float*)d_in[5]; p.w_in_a = (const float*)d_in[6]; p.w_gate_up = (const float*)d_in[7];
    p.b_gate = (const float*)d_in[8]; p.gla_norm_w = (const float*)d_in[9]; p.w_in_b = (const float*)d_in[10]; p.final_norm_w = (const float*)d_in[11];
    p.out = (float*)d_out; p.ws = (unsigned char*)d_ws;
    (void)hipMemsetAsync((unsigned char*)d_ws + WS_BAR, 0, 16384, stream);
#if ONE_LAUNCH
    p.ph_lo = 0; p.ph_hi = NSTEPS;
    void* args[] = {&p};
    hipError_t e = hipLaunchCooperativeKernel((const void*)megak, dim3(grid), dim3(NTHREADS), args, LDS_BYTES, stream);
    if (e != hipSuccess) fprintf(stderr, "cooperative launch failed: %s (grid %d)\n", hipGetErrorString(e), grid);
#else
    for (int s = 0; s < NSTEPS; ++s) {
        p.ph_lo = s; p.ph_hi = s + 1;
        hipLaunchKernelGGL(megak, dim3(grid), dim3(NTHREADS), LDS_BYTES, stream, p);
    }
#endif
}
```

```cpp
#include <hip/hip_runtime.h>
#include <hip/hip_cooperative_groups.h>
#include <cstdio>
namespace cg = cooperative_groups;

#ifndef ONE_LAUNCH
#define ONE_LAUNCH 1
#endif

#ifndef REP_G1
#define REP_G1 1
#endif
#ifndef REP_MIXA
#define REP_MIXA 1
#endif
#ifndef REP_MIXB
#define REP_MIXB 1
#endif
#ifndef REP_BR
#define REP_BR 1
#endif
#ifndef REP_NORM
#define REP_NORM 1
#endif
#define DI __device__ __forceinline__
#define LAS __attribute__((address_space(3)))
typedef unsigned short bf16_t;
typedef short bf16x8 __attribute__((ext_vector_type(8)));
typedef short s16x4 __attribute__((ext_vector_type(4)));
typedef float f32x4 __attribute__((ext_vector_type(4)));
typedef unsigned u32x4 __attribute__((ext_vector_type(4)));
typedef unsigned u32x2 __attribute__((ext_vector_type(2)));
typedef LAS unsigned char* ldsp;

constexpr int BATCH = 32, SEQ = 2048, DM = 1024, MTOK = BATCH * SEQ;
constexpr int GLA_N = 2832, GLA_NP = 3072, DIL_N = 8192;
constexpr int NSLAB = 4, SLAB_B = BATCH / NSLAB, SLAB_ROWS = SLAB_B * SEQ;
constexpr int GA_K = 384, GA_V = 768, GA_GL = 1536, GA_QM = 1552, GA_GATE = 1808;
constexpr int DB_QM = 6912, DB_GATE = 7168;
constexpr int NTHREADS = 512;
constexpr int LDS_WORK = 139264;
constexpr int LDS_BYTES = LDS_WORK + 16;

constexpr size_t WS_WA = 0;
constexpr size_t WS_WB = WS_WA + (size_t)2 * GLA_NP * 1024 * 2;
constexpr size_t WS_WO = WS_WB + (size_t)2 * DIL_N * 1024 * 2;
constexpr size_t WS_WKV = WS_WO + (size_t)4 * 1024 * 1024 * 2;
constexpr size_t WS_MEMN = WS_WKV + (size_t)2048 * 1024 * 2;
constexpr size_t WS_KV = WS_MEMN + (size_t)8192 * 1024 * 2;
constexpr size_t WS_ROPE = WS_KV + (size_t)8192 * 2048 * 2;
constexpr size_t PROJ_SLAB = (size_t)SLAB_ROWS * DIL_N;
constexpr size_t OBUF_SLAB = (size_t)SLAB_ROWS * 2304;
constexpr size_t LSE_SLAB = (size_t)SLAB_ROWS * 18;
constexpr size_t WS_PROJ = WS_ROPE + (size_t)2048 * 16 * 8;
constexpr size_t WS_OBUF = WS_PROJ + 2 * PROJ_SLAB * 2;
constexpr size_t WS_LSE = WS_OBUF + (size_t)MTOK * 768 * 2;
constexpr size_t WS_BR = WS_LSE + 2 * LSE_SLAB * 4;
constexpr size_t DO_H = 0, DO_OBUF2 = (size_t)MTOK * 1024 * 2;
static_assert(2 * PROJ_SLAB >= (size_t)MTOK * GLA_NP && DO_OBUF2 + OBUF_SLAB * 2 <= (size_t)MTOK * 1024 * 4 && OBUF_SLAB <= (size_t)MTOK * 768, "buffer plan");
constexpr size_t WS_BAR = WS_BR + (size_t)MTOK * 1024 * 2;
constexpr size_t WS_SS = WS_BAR + 16384;
constexpr size_t WS_Q0 = WS_SS + (size_t)4 * MTOK * 16 * 4;
constexpr size_t WS_T0P = WS_Q0 + (size_t)BATCH * 768 * 4;
constexpr size_t WS_T0BR = WS_T0P + (size_t)BATCH * 8192 * 4;
constexpr size_t WS_T0X1 = WS_T0BR + (size_t)BATCH * 1024 * 4;
constexpr size_t WS_T0X2 = WS_T0X1 + (size_t)BATCH * 1024 * 4;
constexpr size_t WS_XB = WS_T0X2 + (size_t)BATCH * 1024 * 4;
constexpr size_t WS_END = WS_XB + (size_t)MTOK * 1024 * 2;

struct Params {
    const float *x, *mem, *mem_norm_w, *norm_w, *w_memkv, *w_out, *w_in_a, *w_gate_up, *b_gate, *gla_norm_w, *w_in_b, *final_norm_w;
    float* out; unsigned char* ws; int ph_lo, ph_hi;
};

typedef __bf16 bf16v2_t __attribute__((ext_vector_type(2)));
typedef float f32x2_t __attribute__((ext_vector_type(2)));
DI unsigned cvt_pk_bf16(float lo, float hi) { const f32x2_t v = {lo, hi}; const bf16v2_t b = __builtin_convertvector(v, bf16v2_t); return __builtin_bit_cast(unsigned, b); }
DI float bf_lo(unsigned u) { return __uint_as_float(u << 16); }
DI float bf_hi(unsigned u) { return __uint_as_float(u & 0xffff0000u); }
DI float bf2f(bf16_t b) { return __uint_as_float(((unsigned)b) << 16); }
DI bf16_t f2bf(float f) { return (bf16_t)(cvt_pk_bf16(f, 0.f) & 0xffffu); }
DI f32x4 mfma16(bf16x8 a, bf16x8 b, f32x4 c) { return __builtin_amdgcn_mfma_f32_16x16x32_bf16(a, b, c, 0, 0, 0); }
DI bf16x8 lds_rd8(ldsp p) { return *(LAS bf16x8*)p; }
DI bf16x8 lds_tr8(ldsp p0, ldsp p1) {
    s16x4 lo = __builtin_amdgcn_ds_read_tr16_b64_v4i16((LAS s16x4*)p0);
    s16x4 hi = __builtin_amdgcn_ds_read_tr16_b64_v4i16((LAS s16x4*)p1);
    return __builtin_shufflevector(lo, hi, 0, 1, 2, 3, 4, 5, 6, 7);
}
DI float wave_sum(float v) {
#pragma unroll
    for (int o = 32; o; o >>= 1) v += __shfl_xor(v, o);
    return v;
}
DI float silu_f(float x) { return x / (1.0f + __expf(-x)); }
DI float logsig_f(float x) { return fminf(x, 0.f) - __logf(1.0f + __expf(-fabsf(x))); }


#define XB_TMO      128
#define XB_XCNT(j)  (256  + 64 * (j))
#define XB_XSUB(j)  (1280 + 64 * (j))
#define XB_XGEN(j)  (2304 + 64 * (j))
#define XB_TOP      3328
#define XB_TOPGEN   3392
#define XCD_BAR_WORDS 3456
#define XB_SPIN_CAP (1u << 22)
DI unsigned xb_ld(unsigned* p)              { return __hip_atomic_load(p, __ATOMIC_RELAXED, __HIP_MEMORY_SCOPE_AGENT); }
DI unsigned xb_add(unsigned* p, unsigned v) { return __hip_atomic_fetch_add(p, v, __ATOMIC_RELAXED, __HIP_MEMORY_SCOPE_AGENT); }
DI unsigned xb_xcc_id() { return (unsigned)__builtin_amdgcn_s_getreg((3 << 11) | 20) & 0xFu; }
#define XB_SPIN(cond, bar) do { unsigned _sp = 0; while (cond) { __builtin_amdgcn_s_sleep(1); \
    if ((++_sp & 255u) == 0u) { if (xb_ld(&(bar)[XB_TMO])) break; if (_sp > XB_SPIN_CAP) { atomicAdd(&(bar)[XB_TMO], 1u); break; } } } } while (0)
struct XcdBarrier { unsigned* bar; unsigned x; volatile LAS unsigned* st; };
DI XcdBarrier xcd_barrier_post(unsigned* bar, volatile LAS unsigned* st) {
    XcdBarrier b; b.bar = bar; b.x = xb_xcc_id(); b.st = st;
    if (threadIdx.x == 0) (void)xb_add(&bar[XB_XCNT(b.x)], 1u);
    return b;
}
DI void xcd_barrier_complete(unsigned* bar, unsigned x, unsigned& nloc, unsigned& nx) {
    const unsigned G = gridDim.x * gridDim.y * gridDim.z;
    unsigned sum, cnt, mine, sp = 0u;
    for (;;) {
        sum = 0u; cnt = 0u; mine = 0u;
#pragma unroll
        for (unsigned j = 0; j < 16; ++j) { const unsigned c = xb_ld(&bar[XB_XCNT(j)]); sum += c; cnt += (c > 0u) ? 1u : 0u; mine = (j == x) ? c : mine; }
        if (sum == G) break;
        __builtin_amdgcn_s_sleep(1);
        if ((++sp & 255u) == 0u) { if (xb_ld(&bar[XB_TMO])) break; if (sp > XB_SPIN_CAP) { atomicAdd(&bar[XB_TMO], 1u); break; } }
    }
    nloc = mine > 0u ? mine : 1u; nx = cnt > 0u ? cnt : 1u;
}
DI void xcd_barrier(const XcdBarrier& b) {
    asm volatile("s_waitcnt vmcnt(0)" ::: "memory");
    __syncthreads();
    if (threadIdx.x == 0) {
        unsigned* bar = b.bar;
        __builtin_amdgcn_s_waitcnt(0);
        unsigned nloc = b.st[0], nx = b.st[1];
        if (nloc == 0u) { xcd_barrier_complete(bar, b.x, nloc, nx); b.st[0] = nloc; b.st[1] = nx; }
        const unsigned old = xb_add(&bar[XB_XSUB(b.x)], 1u);
        const unsigned gen = old / nloc;
        if (old + 1u == (gen + 1u) * nloc) {
            __builtin_amdgcn_fence(__ATOMIC_RELEASE, "agent");
            asm volatile("s_waitcnt vmcnt(0)" ::: "memory");
            const unsigned og = xb_add(&bar[XB_TOP], 1u);
            const unsigned tg = og / nx;
            if (og + 1u == (tg + 1u) * nx) xb_add(&bar[XB_TOPGEN], 1u);
            else XB_SPIN(xb_ld(&bar[XB_TOPGEN]) == tg, bar);
            __builtin_amdgcn_fence(__ATOMIC_ACQUIRE, "agent");
            xb_add(&bar[XB_XGEN(b.x)], 1u);
            asm volatile("s_waitcnt vmcnt(0)" ::: "memory");
        } else {
            XB_SPIN(xb_ld(&bar[XB_XGEN(b.x)]) == gen, bar);
            __builtin_amdgcn_fence(__ATOMIC_ACQUIRE, "agent");
            asm volatile("s_waitcnt vmcnt(0)" ::: "memory");
        }
    }
    __syncthreads();
}

namespace pg8 {
constexpr int BM = 256, BK = 64, HALF = 128, HTB = HALF * BK * 2, STAGE_BYTES = 8 * HTB, NXCD = 8, WGM = 8;
DI int lds_byte(int r, int c) { const int st = (r >> 4) * 2 + (c >> 5), rr = r & 15, cc = c & 31, ob = rr * 64 + cc * 2; return st * 1024 + (ob ^ (((ob >> 9) & 1) << 5)); }
DI void stage_rc(int b, int& R, int& C) { const int st = b / 1024, sb = b % 1024, swz = sb ^ (((sb >> 9) & 1) << 5); R = (st >> 1) * 16 + swz / 64; C = (st & 1) * 32 + (swz % 64) / 2; }
DI int perm32(int rho) { const int n = rho >> 4, i = rho & 15; return 8 * (i >> 2) + 4 * n + (i & 3); }
struct Unit { int pm, pn; };
struct Gemm { const bf16_t* A; const bf16_t* Bt; int M, N, K; };
struct StaticOrder {
    int nM, nN, nwg, G, c;
    DI void init(int M, int N, int G_, int c_) { nM = M / BM; nN = N / BM; nwg = nM * nN; G = G_; c = c_; }
    DI bool next(int i, Unit& u) const {
        const long L = (long)i * G + c; if (L >= nwg) return false;
        int wgid = (int)L; { const int q = nwg / NXCD, r = nwg % NXCD, xcd = wgid % NXCD, off = wgid / NXCD; wgid = (xcd < r ? xcd * (q + 1) : r * (q + 1) + (xcd - r) * q) + off; }
        const int nig = WGM * nN, gid = wgid / nig, fm = gid * WGM, gsz = (nM - fm) < WGM ? (nM - fm) : WGM;
        u.pm = fm + ((wgid % nig) % gsz); u.pn = (wgid % nig) / gsz; return true;
    }
};
struct EpiBf {
    static constexpr bool PERM = true;
    bf16_t* O; int ldc;
    DI void operator()(const f32x4 (&acc)[2][2][4][2], const Unit& u, int wr, int wc, int fr, int fq) const {
        const int row0 = u.pm * BM + wr * 64 + fr; const int col0 = u.pn * BM + wc * 32 + 8 * fq;
#pragma unroll
        for (int ai = 0; ai < 2; ++ai)
#pragma unroll
            for (int m = 0; m < 4; ++m) { const int row = row0 + ai * HALF + m * 16; bf16_t* rowp = O + (size_t)row * ldc + col0;
#pragma unroll
                for (int bj = 0; bj < 2; ++bj) { const f32x4 v0 = acc[ai][bj][m][0], v1 = acc[ai][bj][m][1];
                    u32x4 w; w.x = cvt_pk_bf16(v0[0], v0[1]); w.y = cvt_pk_bf16(v0[2], v0[3]); w.z = cvt_pk_bf16(v1[0], v1[1]); w.w = cvt_pk_bf16(v1[2], v1[3]);
                    *(u32x4*)(rowp + bj * HALF) = w; } }
    }
};
struct EpiRes {
    static constexpr bool PERM = true;
    const float* Xf; const bf16_t* Xb; bf16_t* Y;
    DI void operator()(const f32x4 (&acc)[2][2][4][2], const Unit& u, int wr, int wc, int fr, int fq) const {
        const int row0 = u.pm * BM + wr * 64 + fr, col0 = u.pn * BM + wc * 32 + 8 * fq;
        if (Xf) {
#pragma unroll
            for (int ai = 0; ai < 2; ++ai)
#pragma unroll
                for (int mp = 0; mp < 2; ++mp) {
                    f32x4 xf[2][2][2];
#pragma unroll
                    for (int mm = 0; mm < 2; ++mm)
#pragma unroll
                        for (int bj = 0; bj < 2; ++bj) { const float* xp = Xf + (size_t)(row0 + ai * HALF + (2 * mp + mm) * 16) * 1024 + col0 + bj * HALF;
                            xf[mm][bj][0] = *(const f32x4*)xp; xf[mm][bj][1] = *(const f32x4*)(xp + 4); }
#pragma unroll
                    for (int mm = 0; mm < 2; ++mm) { const int m = 2 * mp + mm; const size_t ro = (size_t)(row0 + ai * HALF + m * 16) * 1024 + col0;
#pragma unroll
                        for (int bj = 0; bj < 2; ++bj) {
                            const f32x4 y0 = acc[ai][bj][m][0] + xf[mm][bj][0], y1 = acc[ai][bj][m][1] + xf[mm][bj][1];
                            u32x4 w; w.x = cvt_pk_bf16(y0[0], y0[1]); w.y = cvt_pk_bf16(y0[2], y0[3]); w.z = cvt_pk_bf16(y1[0], y1[1]); w.w = cvt_pk_bf16(y1[2], y1[3]);
                            *(u32x4*)(Y + ro + bj * HALF) = w;
                        }
                    }
                }
        } else {
#pragma unroll
            for (int ai = 0; ai < 2; ++ai) {
                u32x4 xv[4][2];
#pragma unroll
                for (int m = 0; m < 4; ++m)
#pragma unroll
                    for (int bj = 0; bj < 2; ++bj) xv[m][bj] = *(const u32x4*)(Xb + (size_t)(row0 + ai * HALF + m * 16) * 1024 + col0 + bj * HALF);
#pragma unroll
                for (int m = 0; m < 4; ++m) { const size_t ro = (size_t)(row0 + ai * HALF + m * 16) * 1024 + col0;
#pragma unroll
                    for (int bj = 0; bj < 2; ++bj) {
                        const u32x4 x = xv[m][bj];
                        const f32x4 x0 = (f32x4){bf_lo(x.x), bf_hi(x.x), bf_lo(x.y), bf_hi(x.y)}, x1 = (f32x4){bf_lo(x.z), bf_hi(x.z), bf_lo(x.w), bf_hi(x.w)};
                        const f32x4 y0 = acc[ai][bj][m][0] + x0, y1 = acc[ai][bj][m][1] + x1;
                        u32x4 w; w.x = cvt_pk_bf16(y0[0], y0[1]); w.y = cvt_pk_bf16(y0[2], y0[3]); w.z = cvt_pk_bf16(y1[0], y1[1]); w.w = cvt_pk_bf16(y1[2], y1[3]);
                        *(u32x4*)(Y + ro + bj * HALF) = w;
                    }
                }
            }
        }
    }
};

struct PanelOrder {
    int pm;
    DI bool next(int i, Unit& u) const { if (i >= 4) return false; u.pm = pm; u.pn = i; return true; }
};
template <class Epi, class Sched>
DI void gemm_phase(ldsp lds, const Gemm g, const Sched& S, const Epi& E, const int tid) {
    const int wid = __builtin_amdgcn_readfirstlane(tid >> 6), lane = tid & 63, wr = wid >> 2, wc = wid & 3, fr = lane & 15, fq = lane >> 4;
    const int K = g.K, nt = K / BK;
    unsigned voffA[2], voffB[2];
#pragma unroll
    for (int i = 0; i < 2; ++i) { int R, C; stage_rc(tid * 16 + i * 8192, R, C); const int Rb = Epi::PERM ? ((R & ~31) + perm32(R & 31)) : R;
        voffA[i] = (unsigned)(R * K + C) * 2u; voffB[i] = (unsigned)(Rb * K + C) * 2u; }
    const size_t kstep = (size_t)(BK * 2);
    const size_t hstep = (size_t)HALF * K * 2;
    const size_t tstep = 2 * hstep;
    const unsigned ldsw = (unsigned)wid * 1024u;
    const int aoff = lds_byte(wr * 64 + fr, fq * 8), boff = lds_byte(wc * 32 + fr, fq * 8);
#define PG8_SA(b, h) (((b) * 2 + (h)) * HTB)
#define PG8_SB(b, h) ((4 + (b) * 2 + (h)) * HTB)
#define PG8_STAGE(bufoff, gbase, voff) do { _Pragma("unroll") for (int _i = 0; _i < 2; ++_i) \
        __builtin_amdgcn_global_load_lds((const unsigned*)((const char*)(gbase) + (voff)[_i]), (LAS unsigned*)(lds + (bufoff) + ldsw + _i * 8192), 16, 0, 0); } while (0)
#define PG8_LDA(dst, b, h) do { _Pragma("unroll") for (int m = 0; m < 4; ++m) _Pragma("unroll") for (int k = 0; k < 2; ++k) dst[m][k] = *(const LAS bf16x8*)(lds + PG8_SA(b, h) + aoff + m * 2048 + k * 1024); } while (0)
#define PG8_LDB(dst, b, h) do { _Pragma("unroll") for (int n = 0; n < 2; ++n) _Pragma("unroll") for (int k = 0; k < 2; ++k) dst[n][k] = *(const LAS bf16x8*)(lds + PG8_SB(b, h) + boff + n * 2048 + k * 1024); } while (0)
#define PG8_MMA(ai, bj, At, Bt) do { __builtin_amdgcn_s_setprio(1); _Pragma("unroll") for (int m = 0; m < 4; ++m) _Pragma("unroll") for (int n = 0; n < 2; ++n) _Pragma("unroll") for (int k = 0; k < 2; ++k) \
        acc[ai][bj][m][n] = __builtin_amdgcn_mfma_f32_16x16x32_bf16(Bt[n][k], At[m][k], acc[ai][bj][m][n], 0, 0, 0); __builtin_amdgcn_s_setprio(0); } while (0)
#define PG8_WAIT_V(n) asm volatile("s_waitcnt vmcnt(" #n ")" ::: "memory")
#define PG8_WAIT_L(n) asm volatile("s_waitcnt lgkmcnt(" #n ")" ::: "memory")
#define PG8_BAR __builtin_amdgcn_s_barrier()
#define PG8_SCHED __builtin_amdgcn_sched_barrier(0)
    Unit cur, nxt; int ui = 0;
    if (!S.next(0, cur)) return;
    f32x4 acc[2][2][4][2];
#pragma unroll
    for (int a = 0; a < 2; ++a)
#pragma unroll
        for (int b = 0; b < 2; ++b)
#pragma unroll
            for (int m = 0; m < 4; ++m)
#pragma unroll
                for (int n = 0; n < 2; ++n) acc[a][b][m][n] = (f32x4){0.f, 0.f, 0.f, 0.f};
    bf16x8 At[4][2], B0[2][2], B1[2][2];
    const char* cA = (const char*)g.A + (size_t)cur.pm * tstep; const char* cB = (const char*)g.Bt + (size_t)cur.pn * tstep;
    PG8_STAGE(PG8_SB(0, 0), cB, voffB); PG8_STAGE(PG8_SA(0, 0), cA, voffA); PG8_STAGE(PG8_SB(0, 1), cB + hstep, voffB); PG8_STAGE(PG8_SA(0, 1), cA + hstep, voffA);
    if (wr == 1) PG8_BAR;
    PG8_WAIT_V(4); PG8_BAR;
    PG8_STAGE(PG8_SB(1, 0), cB + kstep, voffB); PG8_STAGE(PG8_SA(1, 0), cA + kstep, voffA); PG8_STAGE(PG8_SB(1, 1), cB + hstep + kstep, voffB);
    PG8_WAIT_V(6); PG8_BAR;
    for (;;) {
        const bool has_next = S.next(ui + 1, nxt);
        const char* nA = has_next ? (const char*)g.A + (size_t)nxt.pm * tstep : cA; const char* nB = has_next ? (const char*)g.Bt + (size_t)nxt.pn * tstep : cB;
        for (int t = 0; t < nt; t += 2) {
            const bool last = (t == nt - 2);
            const char* a1 = cA + (size_t)(t + 1) * kstep;
            const char* a2 = last ? nA : cA + (size_t)(t + 2) * kstep; const char* b2 = last ? nB : cB + (size_t)(t + 2) * kstep;
            const char* a3 = a2 + kstep; const char* b3 = b2 + kstep;
            PG8_LDB(B0, 0, 0); PG8_SCHED; PG8_LDA(At, 0, 0); PG8_STAGE(PG8_SA(1, 1), a1 + hstep, voffA);
            PG8_WAIT_L(8); PG8_BAR; PG8_WAIT_L(0); PG8_MMA(0, 0, At, B0); PG8_BAR; PG8_SCHED;
            PG8_LDB(B1, 0, 1); PG8_STAGE(PG8_SB(0, 0), b2, voffB);
            PG8_BAR; PG8_WAIT_L(0); PG8_MMA(0, 1, At, B1); PG8_BAR;
            PG8_LDA(At, 0, 1); PG8_STAGE(PG8_SA(0, 0), a2, voffA);
            PG8_BAR; PG8_WAIT_L(0); PG8_MMA(1, 0, At, B0); PG8_BAR; PG8_SCHED;
            PG8_STAGE(PG8_SB(0, 1), b2 + hstep, voffB);
            PG8_WAIT_V(6); PG8_BAR; PG8_MMA(1, 1, At, B1); PG8_BAR;
            PG8_LDB(B0, 1, 0); PG8_SCHED; PG8_LDA(At, 1, 0); PG8_STAGE(PG8_SA(0, 1), a2 + hstep, voffA);
            PG8_WAIT_L(8); PG8_BAR; PG8_WAIT_L(0); PG8_MMA(0, 0, At, B0); PG8_BAR; PG8_SCHED;
            PG8_LDB(B1, 1, 1); PG8_STAGE(PG8_SB(1, 0), b3, voffB);
            PG8_BAR; PG8_WAIT_L(0); PG8_MMA(0, 1, At, B1); PG8_BAR;
            PG8_LDA(At, 1, 1); PG8_STAGE(PG8_SA(1, 0), a3, voffA);
            PG8_BAR; PG8_WAIT_L(0); PG8_MMA(1, 0, At, B0); PG8_BAR; PG8_SCHED;
            PG8_STAGE(PG8_SB(1, 1), b3 + hstep, voffB);
            PG8_WAIT_V(6); PG8_BAR; PG8_MMA(1, 1, At, B1); PG8_BAR;
        }
        E(acc, cur, wr, wc, fr, fq);
        if (!has_next) break;
#pragma unroll
        for (int a = 0; a < 2; ++a)
#pragma unroll
            for (int b = 0; b < 2; ++b)
#pragma unroll
                for (int m = 0; m < 4; ++m)
#pragma unroll
                    for (int n = 0; n < 2; ++n) acc[a][b][m][n] = (f32x4){0.f, 0.f, 0.f, 0.f};
        cur = nxt; cA = nA; cB = nB; ++ui;
    }
    PG8_WAIT_V(0);
    if (wr == 0) PG8_BAR;
    PG8_BAR;
#undef PG8_SA
#undef PG8_SB
#undef PG8_STAGE
#undef PG8_LDA
#undef PG8_LDB
#undef PG8_MMA
#undef PG8_WAIT_V
#undef PG8_WAIT_L
#undef PG8_BAR
#undef PG8_SCHED
}
}

enum { T_PRO = 0, T_KV, T_G1, T_MIX, T_BR, T_G2, T_NORM, T_NONE };
struct Step { int type, layer, b0, nb; };
__host__ __device__ inline Step decode_step(int s) {
    if (s == 0) return Step{T_PRO, 0, 0, 0};
    if (s == 1) return Step{T_KV, 0, 0, 0};
    s -= 2;
    for (int L = 0; L < 4; ++L) {
        const bool gla = (L % 2) == 0;
        if (gla) {
            if (s < 5) return Step{T_G1 + s, L, 0, BATCH};
            s -= 5;
        } else {
            if (s < 2 * NSLAB) return Step{(s & 1) ? T_MIX : T_G1, L, (s >> 1) * SLAB_B, SLAB_B};
            if (s < 2 * NSLAB + 3) return Step{T_BR + (s - 2 * NSLAB), L, (NSLAB - 1) * SLAB_B, s == 2 * NSLAB ? SLAB_B : BATCH};
            s -= 2 * NSLAB + 3;
        }
    }
    return Step{T_NONE, 0, 0, 0};
}
constexpr int NSTEPS = 2 + 2 * 5 + 2 * (2 * NSLAB + 3);

DI void transpose_w(ldsp lds, const float* W, int N, int Npad, bf16_t* Wt, int tid, const float* kscale = nullptr) {
    const int ntn = Npad / 256, ntiles = ntn * 16;
    LAS float* T = (LAS float*)lds;
    for (int t = blockIdx.x; t < ntiles; t += gridDim.x) {
        const int tn = t % ntn, tk = t / ntn, n0 = tn * 256, k0 = tk * 64;
        float4 v[8];
#pragma unroll
        for (int i = 0; i < 8; ++i) {
            const int e = tid + i * 512, kr = e >> 6, c4 = e & 63, n = n0 + c4 * 4;
            v[i] = make_float4(0.f, 0.f, 0.f, 0.f);
            if (n < N) v[i] = *(const float4*)(W + (size_t)(k0 + kr) * N + n);
        }
#pragma unroll
        for (int i = 0; i < 8; ++i) {
            const int e = tid + i * 512, kr = e >> 6, c4 = e & 63;
            *(LAS f32x4*)(T + kr * 260 + c4 * 4) = (f32x4){v[i].x, v[i].y, v[i].z, v[i].w};
        }
        __syncthreads();
#pragma unroll
        for (int i = 0; i < 4; ++i) {
            const int o = tid + i * 512, n = o & 255, kc = o >> 8;
            float f[8];
#pragma unroll
            for (int j = 0; j < 8; ++j) f[j] = T[(kc * 8 + j) * 260 + n];
            if (kscale) {
#pragma unroll
                for (int j = 0; j < 8; ++j) f[j] *= kscale[k0 + kc * 8 + j]; }
            u32x4 w; w.x = cvt_pk_bf16(f[0], f[1]); w.y = cvt_pk_bf16(f[2], f[3]); w.z = cvt_pk_bf16(f[4], f[5]); w.w = cvt_pk_bf16(f[6], f[7]);
            *(u32x4*)(Wt + (size_t)(n0 + n) * 1024 + k0 + kc * 8) = w;
        }
        __syncthreads();
    }
}

template <bool OUT_BF>
DI void norm_rows(const float* src, const float* w, void* dst, int nrows, int wid, int lane, int gw = -1, int nw = 0) {
    if (gw < 0) { gw = blockIdx.x * 8 + wid; nw = gridDim.x * 8; }
    float4 wv[4];
#pragma unroll
    for (int i = 0; i < 4; ++i) wv[i] = *(const float4*)(w + i * 256 + lane * 4);
    for (int rb = gw; rb < nrows; rb += 2 * nw) {
        float4 v[2][4];
#pragma unroll
        for (int q = 0; q < 2; ++q) { const int r = rb + q * nw; const float4* s = (const float4*)(src + (size_t)(r < nrows ? r : rb) * 1024);
#pragma unroll
            for (int i = 0; i < 4; ++i) v[q][i] = s[i * 64 + lane]; }
#pragma unroll
        for (int q = 0; q < 2; ++q) {
            const int r = rb + q * nw;
            float ss = 0.f;
#pragma unroll
            for (int i = 0; i < 4; ++i) ss += v[q][i].x * v[q][i].x + v[q][i].y * v[q][i].y + v[q][i].z * v[q][i].z + v[q][i].w * v[q][i].w;
            ss = wave_sum(ss);
            const float rs = rsqrtf(ss * (1.0f / 1024.0f) + 1e-6f);
            if (r < nrows) {
#pragma unroll
                for (int i = 0; i < 4; ++i) {
                    const float y0 = v[q][i].x * rs * wv[i].x, y1 = v[q][i].y * rs * wv[i].y, y2 = v[q][i].z * rs * wv[i].z, y3 = v[q][i].w * rs * wv[i].w;
                    if (OUT_BF) { u32x2 o; o.x = cvt_pk_bf16(y0, y1); o.y = cvt_pk_bf16(y2, y3); *(u32x2*)((bf16_t*)dst + (size_t)r * 1024 + i * 256 + lane * 4) = o; }
                    else { *(float4*)((float*)dst + (size_t)r * 1024 + i * 256 + lane * 4) = make_float4(y0, y1, y2, y3); }
                }
            }
        }
    }
}

template <bool OUT_BF>
DI void norm_rows_bf(const bf16_t* src, const float* w, void* dst, int nrows, int lane, int gw, int nw) {
    f32x4 wv[4];
#pragma unroll
    for (int i = 0; i < 2; ++i) { wv[2 * i] = *(const f32x4*)(w + i * 512 + lane * 8); wv[2 * i + 1] = *(const f32x4*)(w + i * 512 + lane * 8 + 4); }
    for (int rb = gw; rb < nrows; rb += 4 * nw) {
        u32x4 a[4][2];
#pragma unroll
        for (int q = 0; q < 4; ++q) { const int r = rb + q * nw; const bf16_t* sp = src + (size_t)(r < nrows ? r : rb) * 1024;
            a[q][0] = *(const u32x4*)(sp + lane * 8); a[q][1] = *(const u32x4*)(sp + 512 + lane * 8); }
#pragma unroll
        for (int q = 0; q < 4; ++q) {
            const int r = rb + q * nw;
            float v[16]; float ss = 0.f;
#pragma unroll
            for (int i = 0; i < 2; ++i)
#pragma unroll
                for (int e = 0; e < 4; ++e) { v[8 * i + 2 * e] = bf_lo(a[q][i][e]); v[8 * i + 2 * e + 1] = bf_hi(a[q][i][e]); }
#pragma unroll
            for (int e = 0; e < 16; ++e) ss += v[e] * v[e];
            ss = wave_sum(ss);
            const float rs = rsqrtf(ss * (1.0f / 1024.0f) + 1e-6f);
            if (r < nrows) {
#pragma unroll
                for (int i = 0; i < 2; ++i) {
                    float y[8];
#pragma unroll
                    for (int e = 0; e < 8; ++e) y[e] = v[8 * i + e] * rs * wv[2 * i + (e >> 2)][e & 3];
                    if (OUT_BF) { u32x4 o; o.x = cvt_pk_bf16(y[0], y[1]); o.y = cvt_pk_bf16(y[2], y[3]); o.z = cvt_pk_bf16(y[4], y[5]); o.w = cvt_pk_bf16(y[6], y[7]);
                        *(u32x4*)((bf16_t*)dst + (size_t)r * 1024 + i * 512 + lane * 8) = o; }
                    else { float* d = (float*)dst + (size_t)r * 1024 + i * 512 + lane * 8; *(f32x4*)d = (f32x4){y[0], y[1], y[2], y[3]}; *(f32x4*)(d + 4) = (f32x4){y[4], y[5], y[6], y[7]}; }
                }
            }
        }
    }
}

DI void cast_rows(const float* src, bf16_t* dst, float* ss, int nrows, int wid, int lane) {
    const int gw = blockIdx.x * 8 + wid, nw = gridDim.x * 8;
    for (int r = gw; r < nrows; r += nw) {
        const float4* sp = (const float4*)(src + (size_t)r * 1024);
        float acc = 0.f;
#pragma unroll
        for (int i = 0; i < 4; ++i) { const float4 v = sp[i * 64 + lane]; acc += v.x * v.x + v.y * v.y + v.z * v.z + v.w * v.w;
            u32x2 o; o.x = cvt_pk_bf16(v.x, v.y); o.y = cvt_pk_bf16(v.z, v.w); *(u32x2*)(dst + (size_t)r * 1024 + i * 256 + lane * 4) = o; }
        acc = wave_sum(acc);
        if (lane < 16) ss[(size_t)r * 16 + lane] = lane == 0 ? acc : 0.f;
    }
}

DI void token0_task(ldsp lds, const float* xcur, size_t xstride, const float* nw, const float* win, float* q0k0, int task, int tid, int wid, int lane) {
    const int b = task >> 3, grp = task & 7;
    LAS float* HX = (LAS float*)lds; LAS float* PART = HX + 1024; LAS float* RED = PART + 21 * 96;
    const float* xr = xcur + (size_t)b * xstride;
    const float v0 = xr[tid], v1 = xr[tid + 512];
    const float sq = wave_sum(v0 * v0 + v1 * v1);
    if (lane == 0) RED[wid] = sq;
    __syncthreads();
    float tot = 0.f;
#pragma unroll
    for (int i = 0; i < 8; ++i) tot += RED[i];
    const float rs = rsqrtf(tot * (1.0f / 1024.0f) + 1e-6f);
    HX[tid] = v0 * rs * nw[tid]; HX[tid + 512] = v1 * rs * nw[tid + 512];
    __syncthreads();
    if (tid < 504) {
        const int g4 = tid % 24, sl = tid / 24, k_lo = sl * 49, k_hi = (k_lo + 49 < 1024) ? k_lo + 49 : 1024;
        f32x4 acc = (f32x4){0.f, 0.f, 0.f, 0.f};
        const float* wp = win + (size_t)k_lo * GLA_N + grp * 96 + g4 * 4;
#pragma unroll 7
        for (int k = k_lo; k < k_hi; ++k, wp += GLA_N) { const f32x4 w = *(const f32x4*)wp; acc += w * HX[k]; }
        *(LAS f32x4*)(PART + sl * 96 + g4 * 4) = acc;
    }
    __syncthreads();
    if (tid < 96) { float a = 0.f;
#pragma unroll
        for (int sl = 0; sl < 21; ++sl) a += PART[sl * 96 + tid];
        q0k0[b * 768 + grp * 96 + tid] = a; }
    __syncthreads();
}


typedef float f32x16 __attribute__((ext_vector_type(16)));
constexpr int T0_XS = 1028;
DI void tok0_gemv(ldsp lds, const float* src, size_t sstride, const float* nw, const float* W, int N, float* Y, int ldy, const float* resid, size_t rstride, int task, int tid, int wid, int lane) {
    LAS float* XS = (LAS float*)lds;
    {
        float4 v[4][4];
#pragma unroll
        for (int q = 0; q < 4; ++q) { const float* xr = src + (size_t)(wid + 8 * q) * sstride;
#pragma unroll
            for (int i = 0; i < 4; ++i) v[q][i] = *(const float4*)(xr + i * 256 + lane * 4); }
        float4 w4[4];
#pragma unroll
        for (int i = 0; i < 4; ++i) { w4[i] = make_float4(1.f, 1.f, 1.f, 1.f); if (nw) w4[i] = *(const float4*)(nw + i * 256 + lane * 4); }
#pragma unroll
        for (int q = 0; q < 4; ++q) {
            const int r = wid + 8 * q;
            float ss = 0.f;
#pragma unroll
            for (int i = 0; i < 4; ++i) ss += v[q][i].x * v[q][i].x + v[q][i].y * v[q][i].y + v[q][i].z * v[q][i].z + v[q][i].w * v[q][i].w;
            float rs = 1.0f;
            if (nw) { ss = wave_sum(ss); rs = rsqrtf(ss * (1.0f / 1024.0f) + 1e-6f); }
#pragma unroll
            for (int i = 0; i < 4; ++i)
                *(LAS f32x4*)(XS + r * T0_XS + i * 256 + lane * 4) = (f32x4){v[q][i].x * rs * w4[i].x, v[q][i].y * rs * w4[i].y, v[q][i].z * rs * w4[i].z, v[q][i].w * rs * w4[i].w};
        }
    }
    __syncthreads();
    const int c0 = task * 32, l31 = lane & 31, kk = lane >> 5, col = c0 + l31; const bool cv = col < N;
    const int kb = wid * 128;
    float wv[64];
#pragma unroll
    for (int q = 0; q < 16; ++q)
#pragma unroll
        for (int e = 0; e < 4; ++e) wv[q * 4 + e] = cv ? W[(size_t)(kb + 8 * q + 4 * kk + e) * N + col] : 0.f;
    f32x16 acc;
#pragma unroll
    for (int i = 0; i < 16; ++i) acc[i] = 0.f;
#pragma unroll
    for (int q = 0; q < 16; ++q) {
        const f32x4 a4 = *(LAS f32x4*)(XS + l31 * T0_XS + kb + 8 * q + 4 * kk);
#pragma unroll
        for (int e = 0; e < 4; ++e) acc = __builtin_amdgcn_mfma_f32_32x32x2f32(a4[e], wv[q * 4 + e], acc, 0, 0, 0);
    }
    __syncthreads();
    LAS float* RED = (LAS float*)lds;
#pragma unroll
    for (int i = 0; i < 16; ++i) RED[(wid * 32 + ((i & 3) + 8 * (i >> 2) + 4 * kk)) * 32 + l31] = acc[i];
    __syncthreads();
    for (int o = tid; o < 1024; o += 512) {
        const int b = o >> 5, c = o & 31, cc = c0 + c;
        float t = 0.f;
#pragma unroll
        for (int w = 0; w < 8; ++w) t += RED[(w * 32 + b) * 32 + c];
        if (cc < N) { if (resid) t += resid[(size_t)b * rstride + cc]; Y[(size_t)b * ldy + cc] = t; }
    }
    __syncthreads();
}
DI void tok0_mem(ldsp lds, const float* qm, const float* memb, const float* mnw, const float* Wkv, int hm, LAS float* out64, int tid, int wid, int lane) {
    LAS float* U = (LAS float*)lds; LAS float* SC = U + 1024; LAS float* RSN = SC + 256; LAS float* MB = RSN + 256; LAS float* QS = MB + 2048; LAS float* PO = QS + 64;
    if (tid < 64) QS[tid] = qm[tid];
    __syncthreads();
#pragma unroll
    for (int h2 = 0; h2 < 2; ++h2) {
        const int j = tid + h2 * 512; const float* wr = Wkv + (size_t)j * 512 + hm * 64; float t = 0.f;
#pragma unroll
        for (int d4 = 0; d4 < 16; ++d4) { const float4 w4 = *(const float4*)(wr + d4 * 4); const f32x4 q4 = *(LAS f32x4*)(QS + d4 * 4); t += w4.x * q4[0] + w4.y * q4[1] + w4.z * q4[2] + w4.w * q4[3]; }
        U[j] = t * mnw[j];
    }
    __syncthreads();
    {
        f32x4 u4[4];
#pragma unroll
        for (int q = 0; q < 4; ++q) u4[q] = *(LAS f32x4*)(U + q * 256 + lane * 4);
        for (int i0 = 0; i0 < 32; i0 += 4) {
            float4 m4[4][4];
#pragma unroll
            for (int r = 0; r < 4; ++r) { const float* mr = memb + (size_t)(wid * 32 + i0 + r) * 1024;
#pragma unroll
                for (int q = 0; q < 4; ++q) m4[r][q] = *(const float4*)(mr + q * 256 + lane * 4); }
#pragma unroll
            for (int r = 0; r < 4; ++r) {
                const int n = wid * 32 + i0 + r; float dd = 0.f, ss = 0.f;
#pragma unroll
                for (int q = 0; q < 4; ++q) { const float4 m = m4[r][q];
                    dd += m.x * u4[q][0] + m.y * u4[q][1] + m.z * u4[q][2] + m.w * u4[q][3]; ss += m.x * m.x + m.y * m.y + m.z * m.z + m.w * m.w; }
                dd = wave_sum(dd); ss = wave_sum(ss);
                if (lane == 0) { const float rstd = rsqrtf(ss * (1.0f / 1024.0f) + 1e-6f); SC[n] = dd * rstd * 0.125f; RSN[n] = rstd; }
            }
        }
    }
    __syncthreads();
    if (wid == 0) {
        float sv[4]; float mx = -INFINITY;
#pragma unroll
        for (int i = 0; i < 4; ++i) { sv[i] = SC[lane + 64 * i]; mx = fmaxf(mx, sv[i]); }
#pragma unroll
        for (int o = 32; o; o >>= 1) mx = fmaxf(mx, __shfl_xor(mx, o));
        float sum = 0.f;
#pragma unroll
        for (int i = 0; i < 4; ++i) { sv[i] = __expf(sv[i] - mx); sum += sv[i]; }
        sum = wave_sum(sum);
        const float is = 1.0f / sum;
#pragma unroll
        for (int i = 0; i < 4; ++i) SC[lane + 64 * i] = sv[i] * is * RSN[lane + 64 * i];
    }
    __syncthreads();
    {
        const int j4 = (tid & 255) * 4, nh = tid >> 8;
        f32x4 acc = (f32x4){0.f, 0.f, 0.f, 0.f};
#pragma unroll 8
        for (int n = nh * 128; n < nh * 128 + 128; ++n) { const float4 m4 = *(const float4*)(memb + (size_t)n * 1024 + j4); const float c = SC[n]; acc[0] += m4.x * c; acc[1] += m4.y * c; acc[2] += m4.z * c; acc[3] += m4.w * c; }
        *(LAS f32x4*)(MB + nh * 1024 + j4) = acc;
    }
    __syncthreads();
#pragma unroll
    for (int h2 = 0; h2 < 2; ++h2) { const int j = tid + h2 * 512; U[j] = (MB[j] + MB[1024 + j]) * mnw[j]; }
    __syncthreads();
    {
        const int d4 = tid & 15, js = tid >> 4;
        f32x4 o = (f32x4){0.f, 0.f, 0.f, 0.f};
#pragma unroll 8
        for (int j = js * 32; j < js * 32 + 32; ++j) { const float4 w4 = *(const float4*)(Wkv + (size_t)j * 512 + 256 + hm * 64 + d4 * 4); const float m = U[j]; o[0] += w4.x * m; o[1] += w4.y * m; o[2] += w4.z * m; o[3] += w4.w * m; }
        *(LAS f32x4*)(PO + js * 64 + d4 * 4) = o;
    }
    __syncthreads();
    if (tid < 64) { float t = 0.f;
#pragma unroll
        for (int js = 0; js < 32; ++js) t += PO[js * 64 + tid];
        out64[tid] = t; }
    __syncthreads();
}
DI void tok0_mix_gla(ldsp lds, const Params& p, const float* P, float* BRo, int task, int tid, int wid, int lane) {
    const int b = task >> 2, hm = task & 3;
    const float* pr = P + (size_t)b * 8192;
    LAS float* OUT = (LAS float*)(lds + 65536); LAS float* R3 = OUT + 64;
    tok0_mem(lds, pr + GA_QM + hm * 64, p.mem + (size_t)b * 256 * 1024, p.mem_norm_w, p.w_memkv, hm, OUT, tid, wid, lane);
    if (tid < 64) BRo[(size_t)b * 1024 + 768 + hm * 64 + tid] = OUT[tid] * silu_f(pr[GA_GATE + 768 + hm * 64 + tid]);
    const float* qp = pr + hm * 96; const float* kp = pr + GA_K + hm * 96;
    const float a = wave_sum(qp[lane] * kp[lane] + (lane < 32 ? qp[64 + lane] * kp[64 + lane] : 0.f)) * 0.10206207261596575f;
    float ve = 0.f;
    if (tid < 192) ve = pr[GA_V + hm * 192 + tid];
    const float sq = wave_sum(ve * ve);
    if (lane == 0 && wid < 3) R3[wid] = sq;
    __syncthreads();
    const float msv = (R3[0] + R3[1] + R3[2]) * (1.0f / 192.0f);
    const float rs = rsqrtf(a * a * msv + 1e-6f);
    if (tid < 192) BRo[(size_t)b * 1024 + hm * 192 + tid] = a * ve * rs * p.gla_norm_w[tid] * silu_f(pr[GA_GATE + hm * 192 + tid]);
    __syncthreads();
}
DI void tok0_mix_dil(ldsp lds, const Params& p, const float* P, float* BRo, int task, int tid, int wid, int lane) {
    const int b = task >> 2, hm = task & 3;
    const float* pr = P + (size_t)b * 8192;
    LAS float* OUT = (LAS float*)(lds + 65536); LAS float* S18 = OUT + 64;
    tok0_mem(lds, pr + DB_QM + hm * 64, p.mem + (size_t)b * 256 * 1024, p.mem_norm_w, p.w_memkv + (size_t)1024 * 512, hm, OUT, tid, wid, lane);
    if (tid < 64) BRo[(size_t)b * 1024 + 768 + hm * 64 + tid] = OUT[tid] * silu_f(pr[DB_GATE + 768 + hm * 64 + tid]);
    if (hm == 0) {
        for (int pi = wid; pi < 18; pi += 8) {
            const int g = pi / 6, head = pi - g * 6;
            const float* qp = pr + g * 2304 + head * 128; const float* kp = qp + 768;
            const float t = wave_sum(qp[lane] * kp[lane] + qp[64 + lane] * kp[64 + lane]) * 0.08838834764831845f;
            if (lane == 0) S18[pi] = t;
        }
        __syncthreads();
        for (int c = tid; c < 768; c += 512) {
            const int head = c >> 7;
            const float l0 = S18[head], l1 = S18[6 + head], l2 = S18[12 + head];
            const float m = fmaxf(l0, fmaxf(l1, l2));
            float e0 = __expf(l0 - m), e1 = __expf(l1 - m), e2 = __expf(l2 - m);
            const float is = 1.0f / (e0 + e1 + e2);
            const float o = (e0 * pr[1536 + c] + e1 * pr[2304 + 1536 + c] + e2 * pr[4608 + 1536 + c]) * is;
            BRo[(size_t)b * 1024 + c] = o * silu_f(pr[DB_GATE + c]);
        }
    }
    __syncthreads();
}

struct DilItem { int g, head, bl, r, ph, jb, s_k0, qcol; size_t rowbase; };
DI DilItem dil_decode(int item) {
    DilItem d;
    const int jb16 = (item + (item >> 8)) & 15; int rest = item >> 4; d.g = rest % 3; rest /= 3; d.head = rest % 6; d.bl = rest / 6;
    const int rsh = 2 * d.g, nbk = 16 >> rsh; d.r = 1 << rsh; d.ph = jb16 >> (4 - rsh); d.jb = jb16 & (nbk - 1);
    d.rowbase = (size_t)d.bl * 2048; d.qcol = d.g * 2304 + d.head * 128; d.s_k0 = 128 * d.jb - 128;
    return d;
}
struct DilPre { u32x4 kc[6], vv[8]; };
constexpr int DIL_KS = 272;

DI void dil_load(DilPre& P, const bf16_t* proj, int item, int tid, int wid, int lane) {
    const DilItem d = dil_decode(item);
    const int kcol = d.qcol + 768, vcol = d.qcol + 1536;
    const u32x4 z = (u32x4){0u, 0u, 0u, 0u};
#pragma unroll
    for (int i = 0; i < 6; ++i) {
        const int e = tid + i * 512, row = e / 12, ch = 4 + (e - row * 12), sp = d.s_k0 + row;
        P.kc[i] = z;
        if (sp >= 0) P.kc[i] = *(const u32x4*)(proj + (d.rowbase + sp * d.r + d.ph) * DIL_N + kcol + ch * 8);
    }
#pragma unroll
    for (int i = 0; i < 8; ++i) {
        const int e = tid + i * 512, row = e >> 4, ch = e & 15, sp = d.s_k0 + row;
        P.vv[i] = z;
        if (sp >= 0) P.vv[i] = *(const u32x4*)(proj + (d.rowbase + sp * d.r + d.ph) * DIL_N + vcol + ch * 8);
    }
}

DI void dil_store(const DilPre& P, bf16x8 (&qf)[4], ldsp lds, const bf16_t* proj, const float* rope, int item, int tid, int wid, int lane) {
    const DilItem d = dil_decode(item);
    const ldsp Kb = lds, Vb = lds + 256 * DIL_KS;
    const int li = lane & 15, quad = lane >> 4;
    const int tq = (128 * d.jb + 16 * wid + li) * d.r + d.ph;
    float4 qcs[4], kcs[4];
    {
        const bf16_t* qsrc = proj + (d.rowbase + tq) * DIL_N + d.qcol + quad * 8;
#pragma unroll
        for (int ks = 0; ks < 4; ++ks) qf[ks] = *(const bf16x8*)(qsrc + ks * 32);
        const float4* rp = (const float4*)(rope + (size_t)tq * 32 + 16 * (quad & 1));
#pragma unroll
        for (int jj = 0; jj < 4; ++jj) qcs[jj] = rp[jj];
    }
    const int prow = tid >> 1, pc = tid & 1, psp = d.s_k0 + prow;
    u32x4 kp1 = (u32x4){0u, 0u, 0u, 0u}, kp2 = kp1;
    {
        const int tok = (psp >= 0 ? psp : 0) * d.r + d.ph;
        const bf16_t* ksrc = proj + (d.rowbase + tok) * DIL_N + d.qcol + 768 + 8 * pc;
        kp1 = *(const u32x4*)ksrc; kp2 = *(const u32x4*)(ksrc + 16);
        const float4* rp = (const float4*)(rope + (size_t)tok * 32 + 16 * pc);
#pragma unroll
        for (int jj = 0; jj < 4; ++jj) kcs[jj] = rp[jj];
    }
#pragma unroll
    for (int i = 0; i < 6; ++i) {
        const int e = tid + i * 512, row = e / 12, ch = 4 + (e - row * 12), sp = d.s_k0 + row;
        if (sp >= 0) *(LAS u32x4*)(Kb + row * DIL_KS + ch * 16) = P.kc[i];
    }
#pragma unroll
    for (int i = 0; i < 8; ++i) {
        const int e = tid + i * 512, row = e >> 4, ch = e & 15, sp = d.s_k0 + row;
        if (sp >= 0) *(LAS u32x4*)(Vb + row * DIL_KS + ch * 16) = P.vv[i];
    }
    if (psp >= 0) {
        u32x4 o1, o2;
#pragma unroll
        for (int jj = 0; jj < 4; ++jj) {
            const float4 cs = kcs[jj];
            const float a0 = bf_lo(kp1[jj]), a1 = bf_hi(kp1[jj]), b0 = bf_lo(kp2[jj]), b1 = bf_hi(kp2[jj]);
            o1[jj] = cvt_pk_bf16(a0 * cs.x - b0 * cs.y, a1 * cs.z - b1 * cs.w);
            o2[jj] = cvt_pk_bf16(a0 * cs.y + b0 * cs.x, a1 * cs.w + b1 * cs.z);
        }
        *(LAS u32x4*)(Kb + prow * DIL_KS + 16 * pc) = o1;
        *(LAS u32x4*)(Kb + prow * DIL_KS + 32 + 16 * pc) = o2;
    }
    {
        const u32x4 mine = __builtin_bit_cast(u32x4, qf[0]);
        u32x4 oth, res;
#pragma unroll
        for (int jj = 0; jj < 4; ++jj) oth[jj] = (unsigned)__shfl_xor((int)mine[jj], 32);
#pragma unroll
        for (int jj = 0; jj < 4; ++jj) {
            const float4 cs = qcs[jj];
            const float m0 = bf_lo(mine[jj]), m1 = bf_hi(mine[jj]), o0 = bf_lo(oth[jj]), o1 = bf_hi(oth[jj]);
            float r0, r1;
            if (quad < 2) { r0 = m0 * cs.x - o0 * cs.y; r1 = m1 * cs.z - o1 * cs.w; }
            else          { r0 = o0 * cs.y + m0 * cs.x; r1 = o1 * cs.w + m1 * cs.z; }
            res[jj] = cvt_pk_bf16(r0, r1);
        }
        qf[0] = __builtin_bit_cast(bf16x8, res);
    }
}

DI void dil_compute(ldsp lds, const bf16x8 (&qf)[4], bf16_t* og, float* lse, int item, int wid, int lane) {
    const DilItem d = dil_decode(item);
    constexpr int KS = DIL_KS;
    const ldsp Kb = lds, Vb = lds + 256 * KS;
    const int li = lane & 15, quad = lane >> 4;
    const int qr = 16 * wid + li, tq = (128 * d.jb + qr) * d.r + d.ph;
    const int s_k0 = d.s_k0;
    const int kt0 = wid >> 1;
    const int kt_lo = (d.jb == 0) ? (4 - kt0) : 0;
    f32x4 sacc[10];
    if (kt_lo == 0) {
        bf16x8 kf[2][4];
        const ldsp ka0 = Kb + (32 * kt0 + li) * KS + quad * 16;
#pragma unroll
        for (int ks = 0; ks < 4; ++ks) kf[0][ks] = lds_rd8(ka0 + ks * 64);
#pragma unroll
        for (int t = 0; t < 10; ++t) {
            if (t + 1 < 10) {
#pragma unroll
                for (int ks = 0; ks < 4; ++ks) kf[(t + 1) & 1][ks] = lds_rd8(ka0 + (t + 1) * 16 * KS + ks * 64);
            }
            __builtin_amdgcn_sched_barrier(0);
            sacc[t] = (f32x4){0.f, 0.f, 0.f, 0.f};
#pragma unroll
            for (int ks = 0; ks < 4; ++ks) sacc[t] = mfma16(kf[t & 1][ks], qf[ks], sacc[t]);
            __builtin_amdgcn_sched_barrier(0);
        }
    } else {
#pragma unroll
        for (int t = 0; t < 10; ++t) {
            sacc[t] = (f32x4){0.f, 0.f, 0.f, 0.f};
            if ((t >> 1) < kt_lo) continue;
            const ldsp ka = Kb + (32 * kt0 + 16 * t + li) * KS + quad * 16;
#pragma unroll
            for (int ks = 0; ks < 4; ++ks) sacc[t] = mfma16(lds_rd8(ka + ks * 64), qf[ks], sacc[t]);
        }
    }
    bf16x8 vfr[2][8];
    const ldsp va0 = Vb + (32 * kt0 + quad * 4 + (li >> 2)) * KS + (li & 3) * 8;
    if (kt_lo == 0) {
#pragma unroll
        for (int dt = 0; dt < 8; ++dt) vfr[0][dt] = lds_tr8(va0 + dt * 32, va0 + 16 * KS + dt * 32);
    }
    const float scale = 0.08838834764831845f;
    float mx = -INFINITY;
#pragma unroll
    for (int t = 0; t < 10; ++t)
#pragma unroll
        for (int j = 0; j < 4; ++j) {
            const int kr = 32 * kt0 + 16 * t + quad * 4 + j, dist = qr + 128 - kr;
            const bool valid = (dist >= 0) && (dist <= 128) && (s_k0 + kr >= 0);
            const float v = valid ? sacc[t][j] * scale : -INFINITY;
            sacc[t][j] = v; mx = fmaxf(mx, v);
        }
    mx = fmaxf(mx, __shfl_xor(mx, 16)); mx = fmaxf(mx, __shfl_xor(mx, 32));
    float den = 0.f;
#pragma unroll
    for (int t = 0; t < 10; ++t)
#pragma unroll
        for (int j = 0; j < 4; ++j) { const float pv = exp2f((sacc[t][j] - mx) * 1.4426950408889634f); sacc[t][j] = pv; den += pv; }
    den += __shfl_xor(den, 16); den += __shfl_xor(den, 32);
    f32x4 oacc[8];
#pragma unroll
    for (int dt = 0; dt < 8; ++dt) oacc[dt] = (f32x4){0.f, 0.f, 0.f, 0.f};
    if (kt_lo == 0) {
#pragma unroll
        for (int kt = 0; kt < 5; ++kt) {
            if (kt + 1 < 5) {
#pragma unroll
                for (int dt = 0; dt < 8; ++dt) vfr[(kt + 1) & 1][dt] = lds_tr8(va0 + (kt + 1) * 32 * KS + dt * 32, va0 + (kt + 1) * 32 * KS + 16 * KS + dt * 32);
            }
            u32x4 pw; pw.x = cvt_pk_bf16(sacc[2 * kt][0], sacc[2 * kt][1]); pw.y = cvt_pk_bf16(sacc[2 * kt][2], sacc[2 * kt][3]);
            pw.z = cvt_pk_bf16(sacc[2 * kt + 1][0], sacc[2 * kt + 1][1]); pw.w = cvt_pk_bf16(sacc[2 * kt + 1][2], sacc[2 * kt + 1][3]);
            const bf16x8 pf = __builtin_bit_cast(bf16x8, pw);
            __builtin_amdgcn_sched_barrier(0);
#pragma unroll
            for (int dt = 0; dt < 8; ++dt) oacc[dt] = mfma16(vfr[kt & 1][dt], pf, oacc[dt]);
            __builtin_amdgcn_sched_barrier(0);
        }
    } else {
#pragma unroll
        for (int kt = 0; kt < 5; ++kt) {
            if (kt < kt_lo) continue;
            u32x4 pw; pw.x = cvt_pk_bf16(sacc[2 * kt][0], sacc[2 * kt][1]); pw.y = cvt_pk_bf16(sacc[2 * kt][2], sacc[2 * kt][3]);
            pw.z = cvt_pk_bf16(sacc[2 * kt + 1][0], sacc[2 * kt + 1][1]); pw.w = cvt_pk_bf16(sacc[2 * kt + 1][2], sacc[2 * kt + 1][3]);
            const bf16x8 pf = __builtin_bit_cast(bf16x8, pw);
            const ldsp va = Vb + (32 * (kt0 + kt) + quad * 4 + (li >> 2)) * KS + (li & 3) * 8;
#pragma unroll
            for (int dt = 0; dt < 8; ++dt) oacc[dt] = mfma16(lds_tr8(va + dt * 32, va + 16 * KS + dt * 32), pf, oacc[dt]);
        }
    }
    const float inv = 1.0f / den;
    bf16_t* dst = og + (d.rowbase + tq) * 2304 + d.g * 768 + d.head * 128 + quad * 4;
#pragma unroll
    for (int dt = 0; dt < 8; ++dt) { u32x2 o; o.x = cvt_pk_bf16(oacc[dt][0] * inv, oacc[dt][1] * inv); o.y = cvt_pk_bf16(oacc[dt][2] * inv, oacc[dt][3] * inv); *(u32x2*)(dst + dt * 16) = o; }
    if (quad == 0) lse[(d.rowbase + tq) * 18 + d.g * 6 + d.head] = mx + __logf(den);
}

struct DilPrev { const bf16_t* og; const float* lse; const bf16_t* proj; bf16_t* br; int b0; };
DI void dil_combine(const bf16_t* og, const float* lse, const bf16_t* proj, bf16_t* br, int b0, int u0, int u1, int ustride);
DI void dil_attn_phase(ldsp lds, const bf16_t* proj, bf16_t* og, float* lse, const float* rope, int nitems, const DilPrev pv, int tid_, int wid_, int lane_) {
    DilPre P;
    int it = blockIdx.x;
    if (it < nitems) dil_load(P, proj, it, tid_, wid_, lane_);
    for (; it < nitems; it += gridDim.x) {
        int tid = tid_; asm volatile("" : "+v"(tid));
        const int wid = __builtin_amdgcn_readfirstlane(tid >> 6), lane = tid & 63;
        bf16x8 qf[4];
        dil_store(P, qf, lds, proj, rope, it, tid, wid, lane);
        __syncthreads();
        if (it + (int)gridDim.x < nitems) dil_load(P, proj, it + gridDim.x, tid, wid, lane);
        dil_compute(lds, qf, og, lse, it, wid, lane);
        if (pv.og) {
            constexpr int PIECE = (SLAB_ROWS * 96 + SLAB_B * 288 - 1) / (SLAB_B * 288);
            const int u0 = it * PIECE, u1 = (u0 + PIECE < SLAB_ROWS * 96) ? u0 + PIECE : SLAB_ROWS * 96;
            dil_combine(pv.og, pv.lse, pv.proj, pv.br, pv.b0, u0 + tid, u1, NTHREADS);
        }
        __syncthreads();
    }
}

DI void mem_attn_item(ldsp lds, const bf16_t* proj, int ldp, int qmcol, int gatecol, const bf16_t* kv, bf16_t* branch, int b0, int item, int tid, int wid, int lane, const bool stage = true) {
    const int qt = item & 15, hm = (item >> 4) & 3, bl = item >> 6;
    constexpr int KS = 144;
    const ldsp Kb = lds, Vb = lds + 256 * KS;
    const bf16_t* kvb = kv + (size_t)(b0 + bl) * 256 * 2048 + hm * 64;
    if (stage)
#pragma unroll
    for (int i = 0; i < 4; ++i) {
        const int e = tid + i * 512, row = e >> 3, ch = e & 7;
        const u32x4 kx = *(const u32x4*)(kvb + (size_t)row * 2048 + ch * 8);
        const u32x4 vx = *(const u32x4*)(kvb + (size_t)row * 2048 + 256 + ch * 8);
        *(LAS u32x4*)(Kb + row * KS + ch * 16) = kx;
        *(LAS u32x4*)(Vb + row * KS + ch * 16) = vx;
    }
    const int li = lane & 15, quad = lane >> 4;
    const int tq = 128 * qt + 16 * wid + li;
    const size_t prow = (size_t)bl * 2048 + tq;
    bf16x8 qf[2];
#pragma unroll
    for (int ks = 0; ks < 2; ++ks) qf[ks] = *(const bf16x8*)(proj + prow * ldp + qmcol + hm * 64 + ks * 32 + quad * 8);
    u32x2 gtv[4];
#pragma unroll
    for (int dt = 0; dt < 4; ++dt) gtv[dt] = *(const u32x2*)(proj + prow * ldp + gatecol + 768 + hm * 64 + quad * 4 + dt * 16);
    __syncthreads();
    f32x4 sacc[16];
#pragma unroll
    for (int t = 0; t < 16; ++t) {
        sacc[t] = (f32x4){0.f, 0.f, 0.f, 0.f};
        const ldsp ka = Kb + (16 * t + li) * KS + quad * 16;
#pragma unroll
        for (int ks = 0; ks < 2; ++ks) sacc[t] = mfma16(lds_rd8(ka + ks * 64), qf[ks], sacc[t]);
    }
    float mx = -INFINITY;
#pragma unroll
    for (int t = 0; t < 16; ++t)
#pragma unroll
        for (int j = 0; j < 4; ++j) { const float v = sacc[t][j] * 0.125f; sacc[t][j] = v; mx = fmaxf(mx, v); }
    mx = fmaxf(mx, __shfl_xor(mx, 16)); mx = fmaxf(mx, __shfl_xor(mx, 32));
    float den = 0.f;
#pragma unroll
    for (int t = 0; t < 16; ++t)
#pragma unroll
        for (int j = 0; j < 4; ++j) { const float pv = exp2f((sacc[t][j] - mx) * 1.4426950408889634f); sacc[t][j] = pv; den += pv; }
    den += __shfl_xor(den, 16); den += __shfl_xor(den, 32);
    f32x4 oacc[4];
#pragma unroll
    for (int dt = 0; dt < 4; ++dt) oacc[dt] = (f32x4){0.f, 0.f, 0.f, 0.f};
#pragma unroll
    for (int kt = 0; kt < 8; ++kt) {
        u32x4 pw; pw.x = cvt_pk_bf16(sacc[2 * kt][0], sacc[2 * kt][1]); pw.y = cvt_pk_bf16(sacc[2 * kt][2], sacc[2 * kt][3]);
        pw.z = cvt_pk_bf16(sacc[2 * kt + 1][0], sacc[2 * kt + 1][1]); pw.w = cvt_pk_bf16(sacc[2 * kt + 1][2], sacc[2 * kt + 1][3]);
        const bf16x8 pf = __builtin_bit_cast(bf16x8, pw);
        const ldsp va = Vb + (32 * kt + quad * 4 + (li >> 2)) * KS + (li & 3) * 8;
#pragma unroll
        for (int dt = 0; dt < 4; ++dt) oacc[dt] = mfma16(lds_tr8(va + dt * 32, va + 16 * KS + dt * 32), pf, oacc[dt]);
    }
    const float inv = 1.0f / den;
    bf16_t* dst = branch + ((size_t)(b0 + bl) * 2048 + tq) * 1024 + 768 + hm * 64 + quad * 4;
#pragma unroll
    for (int dt = 0; dt < 4; ++dt) {
        const u32x2 gt = gtv[dt];
        u32x2 o;
        o.x = cvt_pk_bf16(oacc[dt][0] * inv * silu_f(bf_lo(gt.x)), oacc[dt][1] * inv * silu_f(bf_hi(gt.x)));
        o.y = cvt_pk_bf16(oacc[dt][2] * inv * silu_f(bf_lo(gt.y)), oacc[dt][3] * inv * silu_f(bf_hi(gt.y)));
        *(u32x2*)(dst + dt * 16) = o;
    }
    __syncthreads();
}

DI void gla_item(ldsp lds, const Params& p, const bf16_t* proj, bf16_t* obuf, const float* q0k0, int jl, int item, int tid, int wid, int lane) {
    const int half = item & 1, h = (item >> 1) & 3, b = item >> 3;
    constexpr int O_GL = 0, O_WG = 5120, O_BG = 12800, O_LA = 13312, O_QI = 38912, O_KI = 52224, O_KO = 65536, O_V = 78848, O_AM = 92160, O_ST = 101376;
    constexpr int S96 = 208, SGL = 80, SAM = 144, SLA = 100;
    const ldsp GL = lds + O_GL, WG = lds + O_WG, QI = lds + O_QI, KI = lds + O_KI, KO = lds + O_KO, Vl = lds + O_V, AM = lds + O_AM, ST = lds + O_ST;
    LAS float* BG = (LAS float*)(lds + O_BG);
    LAS float* LA = (LAS float*)(lds + O_LA);
    const int li = lane & 15, quad = lane >> 4;
    {
        float wv6[6];
#pragma unroll
        for (int i = 0; i < 6; ++i) { const int e = tid + i * 512, d = e >> 5, kk = e & 31;
            wv6[i] = kk < 16 ? p.w_gate_up[(size_t)(jl * 16 + kk) * 384 + h * 96 + d] : 0.f; }
#pragma unroll
        for (int i = 0; i < 6; ++i) { const int e = tid + i * 512, d = e >> 5, kk = e & 31; *(LAS bf16_t*)(WG + d * SGL + kk * 2) = f2bf(wv6[i]); }
    }
    for (int e = tid; e < 64 * 40; e += 512) *(LAS bf16_t*)(GL + e * 2) = 0;
    if (tid < 96) BG[tid] = p.b_gate[jl * 384 + h * 96 + tid];
    float a00;
    {
        const float* qp = q0k0 + b * 768 + h * 96; const float* kp = qp + 384;
        float t = qp[lane] * kp[lane] + (lane < 32 ? qp[64 + lane] * kp[64 + lane] : 0.f);
        a00 = wave_sum(t) * 0.10206207261596575f;
    }
    f32x4 S[6];
#pragma unroll
    for (int i = 0; i < 6; ++i) S[i] = (f32x4){0.f, 0.f, 0.f, 0.f};
    __syncthreads();
    const int c0 = tid, c1 = tid + 512;
    const int row0 = c0 / 12, ch0 = c0 - row0 * 12, row1 = c1 / 12, ch1 = c1 - row1 * 12;
    const bool has1 = tid < 256;
    u32x4 qreg0, kreg0, vreg0, qreg1 = (u32x4){0u, 0u, 0u, 0u}, kreg1 = qreg1, vreg1 = qreg1, greg = qreg1;
#define GLA_LOAD_CHUNK(nn) do { const size_t rb_ = (size_t)b * 2048 + (nn) * 64; \
        const bf16_t* r0p = proj + (rb_ + row0) * GLA_NP; \
        qreg0 = *(const u32x4*)(r0p + h * 96 + ch0 * 8); kreg0 = *(const u32x4*)(r0p + GA_K + h * 96 + ch0 * 8); \
        vreg0 = *(const u32x4*)(r0p + GA_V + h * 192 + half * 96 + ch0 * 8); \
        if (has1) { const bf16_t* r1p = proj + (rb_ + row1) * GLA_NP; \
            qreg1 = *(const u32x4*)(r1p + h * 96 + ch1 * 8); kreg1 = *(const u32x4*)(r1p + GA_K + h * 96 + ch1 * 8); \
            vreg1 = *(const u32x4*)(r1p + GA_V + h * 192 + half * 96 + ch1 * 8); } \
        if (tid < 128) greg = *(const u32x4*)(proj + (rb_ + (tid >> 1)) * GLA_NP + GA_GL + (tid & 1) * 8); } while (0)
    GLA_LOAD_CHUNK(0);
    for (int n = 0; n < 32; ++n) {
        const size_t rowb = (size_t)b * 2048 + n * 64;
        *(LAS u32x4*)(Vl + row0 * S96 + ch0 * 16) = vreg0;
        if (has1) *(LAS u32x4*)(Vl + row1 * S96 + ch1 * 16) = vreg1;
        if (tid < 128) *(LAS u32x4*)(GL + (tid >> 1) * SGL + (tid & 1) * 16) = greg;
        __syncthreads();
        if (wid < 6) {
            const int d = 16 * wid + li; const float bias = BG[d];
            const bf16x8 bb = lds_rd8(WG + (16 * wid + li) * SGL + quad * 16);
            float base = 0.f;
#pragma unroll
            for (int it = 0; it < 4; ++it) {
                const bf16x8 a = lds_rd8(GL + (16 * it + li) * SGL + quad * 16);
                const f32x4 c = mfma16(a, bb, (f32x4){0.f, 0.f, 0.f, 0.f});
                const float c0 = logsig_f(c[0] + bias) * (1.0f / 16.0f);
                const float c1 = c0 + logsig_f(c[1] + bias) * (1.0f / 16.0f);
                const float c2 = c1 + logsig_f(c[2] + bias) * (1.0f / 16.0f);
                const float c3 = c2 + logsig_f(c[3] + bias) * (1.0f / 16.0f);
                float sc = c3;
                float t = __shfl_up(sc, 16); if (quad >= 1) sc += t;
                t = __shfl_up(sc, 32); if (quad >= 2) sc += t;
                const float tot = __shfl(sc, 48 + li);
                const float o = base + (sc - c3);
                LAS float* lp = LA + (16 * it + quad * 4) * SLA + d;
                lp[0] = o + c0; lp[SLA] = o + c1; lp[2 * SLA] = o + c2; lp[3 * SLA] = o + c3;
                base += tot;
            }
#pragma unroll
            for (int dt = 0; dt < 6; ++dt) { u32x2 w; w.x = cvt_pk_bf16(S[dt][0], S[dt][1]); w.y = cvt_pk_bf16(S[dt][2], S[dt][3]);
                *(LAS u32x2*)(ST + (16 * wid + li) * S96 + (16 * dt + quad * 4) * 2) = w; }
        }
        __syncthreads();
#pragma unroll
        for (int cc = 0; cc < 2; ++cc) {
            if (cc == 1 && !has1) break;
            const int row = cc ? row1 : row0, ch = cc ? ch1 : ch0;
            const u32x4 qv = cc ? qreg1 : qreg0, kv = cc ? kreg1 : kreg0;
            const f32x4 b0v = *(LAS f32x4*)(LA + row * SLA + ch * 8), b1v = *(LAS f32x4*)(LA + row * SLA + ch * 8 + 4);
            const f32x4 l0v = *(LAS f32x4*)(LA + 63 * SLA + ch * 8), l1v = *(LAS f32x4*)(LA + 63 * SLA + ch * 8 + 4);
            u32x4 qi, ki, ko;
#pragma unroll
            for (int e2 = 0; e2 < 4; ++e2) {
                const float bA = e2 < 2 ? b0v[2 * e2] : b1v[2 * e2 - 4], bB = e2 < 2 ? b0v[2 * e2 + 1] : b1v[2 * e2 - 3];
                const float lA = e2 < 2 ? l0v[2 * e2] : l1v[2 * e2 - 4], lB = e2 < 2 ? l0v[2 * e2 + 1] : l1v[2 * e2 - 3];
                const float qa = bf_lo(qv[e2]), qb = bf_hi(qv[e2]), ka = bf_lo(kv[e2]), kb = bf_hi(kv[e2]);
                qi[e2] = cvt_pk_bf16(qa * 0.10206207261596575f * __expf(bA), qb * 0.10206207261596575f * __expf(bB));
                ki[e2] = cvt_pk_bf16(ka * __expf(-bA), kb * __expf(-bB));
                ko[e2] = cvt_pk_bf16(ka * __expf(lA - bA), kb * __expf(lB - bB));
            }
            *(LAS u32x4*)(QI + row * S96 + ch * 16) = qi;
            *(LAS u32x4*)(KI + row * S96 + ch * 16) = ki;
            *(LAS u32x4*)(KO + row * S96 + ch * 16) = ko;
        }
        if (n + 1 < 32) GLA_LOAD_CHUNK(n + 1);
        __syncthreads();
#pragma unroll
        for (int i = 0; i < 2; ++i) {
            const int tile = wid + 8 * i, ti = tile >> 2, tj = tile & 3;
            u32x2 w = (u32x2){0u, 0u};
            if (tj <= ti) {
                f32x4 c = (f32x4){0.f, 0.f, 0.f, 0.f};
#pragma unroll
                for (int ks = 0; ks < 3; ++ks) c = mfma16(lds_rd8(KI + (16 * tj + li) * S96 + (ks * 32 + quad * 8) * 2), lds_rd8(QI + (16 * ti + li) * S96 + (ks * 32 + quad * 8) * 2), c);
                const int ii = 16 * ti + li, j0 = 16 * tj + quad * 4;
                if (n == 0 && tile == 0 && li == 0 && quad == 0) c[0] = a00;
                w.x = cvt_pk_bf16(j0 <= ii ? c[0] : 0.f, j0 + 1 <= ii ? c[1] : 0.f);
                w.y = cvt_pk_bf16(j0 + 2 <= ii ? c[2] : 0.f, j0 + 3 <= ii ? c[3] : 0.f);
            }
            *(LAS u32x2*)(AM + (16 * ti + li) * SAM + (16 * tj + quad * 4) * 2) = w;
        }
        __syncthreads();
        if (wid < 6) {
            const int e0 = 16 * wid;
            bf16x8 vf[2];
#pragma unroll
            for (int ks = 0; ks < 2; ++ks) { const ldsp a0 = Vl + (32 * ks + quad * 8 + (li >> 2)) * S96 + (e0 + 4 * (li & 3)) * 2; vf[ks] = lds_tr8(a0, a0 + 4 * S96); }
            f32x4 o[4];
#pragma unroll
            for (int ti = 0; ti < 4; ++ti) { o[ti] = (f32x4){0.f, 0.f, 0.f, 0.f};
#pragma unroll
                for (int ks = 0; ks < 2; ++ks) if (2 * ks <= ti) o[ti] = mfma16(vf[ks], lds_rd8(AM + (16 * ti + li) * SAM + (32 * ks + quad * 8) * 2), o[ti]); }
#pragma unroll
            for (int ks = 0; ks < 3; ++ks) { const bf16x8 a = lds_rd8(ST + (e0 + li) * S96 + (32 * ks + quad * 8) * 2);
#pragma unroll
                for (int ti = 0; ti < 4; ++ti) o[ti] = mfma16(a, lds_rd8(QI + (16 * ti + li) * S96 + (32 * ks + quad * 8) * 2), o[ti]); }
#pragma unroll
            for (int ti = 0; ti < 4; ++ti) { u32x2 w; w.x = cvt_pk_bf16(o[ti][0], o[ti][1]); w.y = cvt_pk_bf16(o[ti][2], o[ti][3]);
                *(u32x2*)(obuf + (rowb + 16 * ti + li) * 768 + h * 192 + half * 96 + e0 + quad * 4) = w; }
#pragma unroll
            for (int dt = 0; dt < 6; ++dt) {
                const f32x4 lb = *(LAS f32x4*)(LA + 63 * SLA + 16 * dt + quad * 4);
#pragma unroll
                for (int jj = 0; jj < 4; ++jj) S[dt][jj] *= __expf(lb[jj]);
#pragma unroll
                for (int ks = 0; ks < 2; ++ks) { const ldsp a0 = KO + (32 * ks + quad * 8 + (li >> 2)) * S96 + (16 * dt + 4 * (li & 3)) * 2; S[dt] = mfma16(lds_tr8(a0, a0 + 4 * S96), vf[ks], S[dt]); }
            }
        }
        __syncthreads();
    }
}

#undef GLA_LOAD_CHUNK
DI void dil_combine(const bf16_t* og, const float* lse, const bf16_t* proj, bf16_t* br, int b0, int u0, int u1, int ustride) {
    for (int u = u0; u < u1; u += ustride) {
        const int row = u / 96, ch = u - row * 96, head = ch >> 4;
        const float l0 = lse[(size_t)row * 18 + head], l1 = lse[(size_t)row * 18 + 6 + head], l2 = lse[(size_t)row * 18 + 12 + head];
        const float m = fmaxf(l0, fmaxf(l1, l2));
        float e0 = __expf(l0 - m), e1 = __expf(l1 - m), e2 = __expf(l2 - m);
        const float is = 1.0f / (e0 + e1 + e2); e0 *= is; e1 *= is; e2 *= is;
        const bf16_t* ob = og + (size_t)row * 2304 + ch * 8;
        const u32x4 a = *(const u32x4*)ob, bq = *(const u32x4*)(ob + 768), c = *(const u32x4*)(ob + 1536);
        const u32x4 gv = *(const u32x4*)(proj + (size_t)row * DIL_N + DB_GATE + ch * 8);
        u32x4 w;
#pragma unroll
        for (int e = 0; e < 4; ++e) {
            const float vlo = e0 * bf_lo(a[e]) + e1 * bf_lo(bq[e]) + e2 * bf_lo(c[e]);
            const float vhi = e0 * bf_hi(a[e]) + e1 * bf_hi(bq[e]) + e2 * bf_hi(c[e]);
            w[e] = cvt_pk_bf16(vlo * silu_f(bf_lo(gv[e])), vhi * silu_f(bf_hi(gv[e])));
        }
        *(u32x4*)(br + ((size_t)b0 * SEQ + row) * 1024 + ch * 8) = w;
    }
}
__global__ void __launch_bounds__(NTHREADS, 2) megak(Params p) {
    extern __shared__ __attribute__((aligned(16))) unsigned char shm[];
    const ldsp lds = (ldsp)shm;
    cg::grid_group grid = cg::this_grid();
    unsigned char* ws = p.ws;
    bf16_t* WA = (bf16_t*)(ws + WS_WA); bf16_t* WB = (bf16_t*)(ws + WS_WB); bf16_t* WO = (bf16_t*)(ws + WS_WO); bf16_t* WKV = (bf16_t*)(ws + WS_WKV);
    bf16_t* MEMN = (bf16_t*)(ws + WS_MEMN); bf16_t* KV = (bf16_t*)(ws + WS_KV); float* ROPE = (float*)(ws + WS_ROPE);
    bf16_t* H = (bf16_t*)((unsigned char*)p.out + DO_H); bf16_t* PROJ = (bf16_t*)(ws + WS_PROJ); bf16_t* OBUF = (bf16_t*)(ws + WS_OBUF); bf16_t* OBUF2 = (bf16_t*)((unsigned char*)p.out + DO_OBUF2);
    float* LSE = (float*)(ws + WS_LSE); bf16_t* BR = (bf16_t*)(ws + WS_BR); float* SS = (float*)(ws + WS_SS); float* Q0K0 = (float*)(ws + WS_Q0);
    float* T0P = (float*)(ws + WS_T0P); float* T0BR = (float*)(ws + WS_T0BR); float* T0X1 = (float*)(ws + WS_T0X1); float* T0X2 = (float*)(ws + WS_T0X2); bf16_t* XB = (bf16_t*)(ws + WS_XB);
    volatile LAS unsigned* bst = (volatile LAS unsigned*)(lds + LDS_WORK);
    if (threadIdx.x == 0) { bst[0] = 0u; bst[1] = 0u; }
    __syncthreads();
    const XcdBarrier xb = xcd_barrier_post((unsigned*)(ws + WS_BAR), bst);
    for (int s = p.ph_lo; s < p.ph_hi; ++s) {
        int tid = threadIdx.x;
        const Step st = decode_step(s);
        const int L = st.layer, jl = L >> 1; const bool gla = (L & 1) == 0;
        int nrep = 1;
        if (st.type == T_G1) nrep = REP_G1;
        if (st.type == T_MIX) nrep = gla ? REP_MIXA : REP_MIXB;
        if (st.type == T_BR) nrep = REP_BR;
        for (int rep = 0; rep < nrep; ++rep) {
        if (rep) xcd_barrier(xb);
        asm volatile("" : "+v"(tid));
        const int wid = __builtin_amdgcn_readfirstlane(tid >> 6), lane = tid & 63;
        const int gtid = blockIdx.x * NTHREADS + tid, gthreads = gridDim.x * NTHREADS;
        switch (st.type) {
        case T_PRO: {
            for (int j = 0; j < 2; ++j) transpose_w(lds, p.w_in_a + (size_t)j * 1024 * GLA_N, GLA_N, GLA_NP, WA + (size_t)j * GLA_NP * 1024, tid);
            for (int j = 0; j < 2; ++j) transpose_w(lds, p.w_in_b + (size_t)j * 1024 * DIL_N, DIL_N, DIL_N, WB + (size_t)j * DIL_N * 1024, tid);
            for (int j = 0; j < 4; ++j) transpose_w(lds, p.w_out + (size_t)j * 1024 * 1024, 1024, 1024, WO + (size_t)j * 1024 * 1024, tid);
            for (int j = 0; j < 4; ++j) transpose_w(lds, p.w_memkv + (size_t)j * 1024 * 512, 512, 512, WKV + (size_t)j * 512 * 1024, tid);
            norm_rows<true>(p.mem, p.mem_norm_w, MEMN, BATCH * 256, wid, lane);
            for (int e = gtid; e < 2048 * 16; e += gthreads) {
                const int pos = e >> 4, i = e & 15;
                const float inv = exp2f(-(float)i * 1.1832230355827609f);
                const float ang = (float)pos * inv;
                const double a = (double)ang;
                const double k = rint(a * 0.15915494309189535);
                const float rf = (float)(a - k * 6.283185307179586);
                ROPE[2 * e] = __cosf(rf); ROPE[2 * e + 1] = __sinf(rf);
            }
        } break;
        case T_KV: {
            pg8::Gemm g{MEMN, WKV, BATCH * 256, 2048, 1024};
            pg8::StaticOrder so; so.init(g.M, g.N, (int)gridDim.x, (int)blockIdx.x);
            pg8::EpiBf ep{KV, 2048};
            pg8::gemm_phase<pg8::EpiBf, pg8::StaticOrder>(lds, g, so, ep, tid);
            norm_rows<true>(p.x, p.norm_w, H, MTOK, wid, lane);
            __syncthreads();
            for (int t = blockIdx.x; t < 89; t += gridDim.x)
                tok0_gemv(lds, p.x, (size_t)SEQ * 1024, p.norm_w, p.w_in_a, GLA_N, T0P, 8192, nullptr, 0, t, tid, wid, lane);
        } break;
        case T_G1: {
            pg8::Gemm g; pg8::EpiBf ep;
            if (gla) { g = pg8::Gemm{H, WA + (size_t)jl * GLA_NP * 1024, MTOK, GLA_NP, 1024}; ep = pg8::EpiBf{PROJ, GLA_NP}; }
            else     { g = pg8::Gemm{H + (size_t)st.b0 * SEQ * 1024, WB + (size_t)jl * DIL_N * 1024, SLAB_ROWS, DIL_N, 1024}; ep = pg8::EpiBf{PROJ + ((st.b0 / SLAB_B) & 1) * PROJ_SLAB, DIL_N}; }
            pg8::StaticOrder so; so.init(g.M, g.N, (int)gridDim.x, (int)blockIdx.x);
            pg8::gemm_phase<pg8::EpiBf, pg8::StaticOrder>(lds, g, so, ep, tid);
            if (gla) {
                __syncthreads();
                for (int t = blockIdx.x; t < BATCH * 8; t += gridDim.x)
                    token0_task(lds, L == 0 ? p.x : T0X2, L == 0 ? (size_t)SEQ * 1024 : (size_t)1024, p.norm_w + L * 1024, p.w_in_a + (size_t)jl * 1024 * GLA_N, Q0K0, t, tid, wid, lane);
                if (L == 0) for (int t = blockIdx.x; t < BATCH * 4; t += gridDim.x) tok0_mix_gla(lds, p, T0P, T0BR, t, tid, wid, lane);
            } else if (L == 1 && st.b0 == 0) {
                __syncthreads();
                for (int t = blockIdx.x; t < 32; t += gridDim.x)
                    tok0_gemv(lds, T0BR, 1024, nullptr, p.w_out + (size_t)1024 * 1024, 1024, T0X2, 1024, T0X1, 1024, t, tid, wid, lane);
            }
        } break;
        case T_MIX: {
            const bf16_t* kvl = KV + L * 512;
            if (gla) {
                for (int it = blockIdx.x; it < BATCH * 8; it += gridDim.x) gla_item(lds, p, PROJ, OBUF, Q0K0, jl, it, tid, wid, lane);
                if (gridDim.x == 256) {
                    const int grp = blockIdx.x >> 1;
                    for (int j = 0; j < 8; ++j) mem_attn_item(lds, PROJ, GLA_NP, GA_QM, GA_GATE, kvl, BR, 0, ((blockIdx.x & 1) * 8 + j) + 16 * grp, tid, wid, lane, j == 0);
                } else
                for (int it = blockIdx.x; it < BATCH * 64; it += gridDim.x) mem_attn_item(lds, PROJ, GLA_NP, GA_QM, GA_GATE, kvl, BR, 0, it, tid, wid, lane);
                if (L == 0) for (int t = blockIdx.x; t < 32; t += gridDim.x)
                    tok0_gemv(lds, T0BR, 1024, nullptr, p.w_out, 1024, T0X1, 1024, p.x, (size_t)SEQ * 1024, t, tid, wid, lane);
            } else {
                const int sl = st.b0 / SLAB_B, par = sl & 1;
                const bf16_t* PJ = PROJ + par * PROJ_SLAB;
                DilPrev pv{nullptr, nullptr, nullptr, nullptr, 0};
                if (sl > 0) pv = DilPrev{par ? OBUF : OBUF2, LSE + (par ^ 1) * LSE_SLAB, PROJ + (par ^ 1) * PROJ_SLAB, BR, st.b0 - SLAB_B};
                dil_attn_phase(lds, PJ, par ? OBUF2 : OBUF, LSE + par * LSE_SLAB, ROPE, SLAB_B * 288, pv, tid, wid, lane);
                if (gridDim.x == 256) {
                    const int grp = blockIdx.x >> 3;
                    for (int j = 0; j < 2; ++j) mem_attn_item(lds, PJ, DIL_N, DB_QM, DB_GATE, kvl, BR, st.b0, ((blockIdx.x & 7) * 2 + j) + 16 * grp, tid, wid, lane, j == 0);
                } else
                for (int it = blockIdx.x; it < SLAB_B * 64; it += gridDim.x) mem_attn_item(lds, PJ, DIL_N, DB_QM, DB_GATE, kvl, BR, st.b0, it, tid, wid, lane);
            }
        } break;
        case T_BR: {
            if (gla) {
                const int l32 = lane & 31; const bool act = l32 < 24;
                const int hw0 = (blockIdx.x * 8 + wid) * 2 + (lane >> 5), nhw = gridDim.x * 16;
                f32x4 g0 = (f32x4){0.f, 0.f, 0.f, 0.f}, g1 = g0;
                if (act) { g0 = *(const f32x4*)(p.gla_norm_w + jl * 192 + l32 * 8); g1 = *(const f32x4*)(p.gla_norm_w + jl * 192 + l32 * 8 + 4); }
                for (int ub = hw0; ub < MTOK * 4; ub += 4 * nhw) {
                    u32x4 ovq[4], gvq[4];
#pragma unroll
                    for (int q = 0; q < 4; ++q) {
                        const int u = ub + q * nhw, uu = u < MTOK * 4 ? u : ub, tok = uu >> 2, hh = uu & 3;
                        ovq[q] = (u32x4){0u, 0u, 0u, 0u}; gvq[q] = ovq[q];
                        if (act) { ovq[q] = *(const u32x4*)(OBUF + (size_t)tok * 768 + hh * 192 + l32 * 8); gvq[q] = *(const u32x4*)(PROJ + (size_t)tok * GLA_NP + GA_GATE + hh * 192 + l32 * 8); }
                    }
#pragma unroll
                    for (int q = 0; q < 4; ++q) {
                        const int u = ub + q * nhw, tok = u >> 2, hh = u & 3;
                        float o[8], gt[8];
#pragma unroll
                        for (int e = 0; e < 4; ++e) { o[2 * e] = bf_lo(ovq[q][e]); o[2 * e + 1] = bf_hi(ovq[q][e]); gt[2 * e] = bf_lo(gvq[q][e]); gt[2 * e + 1] = bf_hi(gvq[q][e]); }
                        float ss = 0.f;
#pragma unroll
                        for (int e = 0; e < 8; ++e) ss += o[e] * o[e];
#pragma unroll
                        for (int m = 16; m; m >>= 1) ss += __shfl_xor(ss, m);
                        const float rs = rsqrtf(ss * (1.0f / 192.0f) + 1e-6f);
                        if (act && u < MTOK * 4) {
                            u32x4 w;
#pragma unroll
                            for (int e = 0; e < 4; ++e) {
                                const float wa = e < 2 ? g0[2 * e] : g1[2 * e - 4], wb = e < 2 ? g0[2 * e + 1] : g1[2 * e - 3];
                                w[e] = cvt_pk_bf16(o[2 * e] * rs * wa * silu_f(gt[2 * e]), o[2 * e + 1] * rs * wb * silu_f(gt[2 * e + 1]));
                            }
                            *(u32x4*)(BR + (size_t)tok * 1024 + hh * 192 + l32 * 8) = w;
                        }
                    }
                }
                if (L == 0) for (int t = blockIdx.x; t < 256; t += gridDim.x)
                    tok0_gemv(lds, T0X1, 1024, p.norm_w + 1024, p.w_in_b, DIL_N, T0P, 8192, nullptr, 0, t, tid, wid, lane);
            } else {
                const int par = (st.b0 / SLAB_B) & 1;
                dil_combine(par ? OBUF2 : OBUF, LSE + par * LSE_SLAB, PROJ + par * PROJ_SLAB, BR, st.b0, gtid, SLAB_ROWS * 96, gthreads);
            }
        } break;
        case T_G2: {
            pg8::Gemm g{BR, WO + (size_t)L * 1024 * 1024, MTOK, 1024, 1024};
            pg8::StaticOrder so; so.init(g.M, g.N, (int)gridDim.x, (int)blockIdx.x);
            pg8::EpiRes ep{L == 0 ? p.x : nullptr, XB, XB};
            pg8::gemm_phase<pg8::EpiRes, pg8::StaticOrder>(lds, g, so, ep, tid);
            if (L == 0) {
                __syncthreads();
                for (int t = blockIdx.x; t < BATCH * 4; t += gridDim.x) tok0_mix_dil(lds, p, T0P, T0BR, t, tid, wid, lane);
            }
        } break;
        case T_NORM: {
            if (L < 3) norm_rows_bf<true>(XB, p.norm_w + (L + 1) * 1024, H, MTOK, lane, blockIdx.x * 8 + wid, gridDim.x * 8);
            else norm_rows_bf<false>(XB, p.final_norm_w, p.out, MTOK, lane, blockIdx.x * 8 + wid, gridDim.x * 8);
        } break;
        default: break;
        }
        }
        if (s + 1 < p.ph_hi) { if (p.ph_hi > 1000) grid.sync(); else xcd_barrier(xb); }
    }
}

extern "C" void kernel_launch(void* const* d_in, const int* in_sizes, int n_in, void* d_out, int out_size, void* d_ws, size_t ws_size, hipStream_t stream) {
    static int grid = 0;
    if (grid == 0) {
        if (n_in != 12 || in_sizes[0] != MTOK * DM || out_size != MTOK * DM || ws_size < WS_END) {
            fprintf(stderr, "kernel_launch: unexpected shapes / workspace (n_in %d in0 %d out %d ws %zu need %zu)\n", n_in, n_in > 0 ? in_sizes[0] : -1, out_size, ws_size, (size_t)WS_END);
            grid = -1; return;
        }
        int dev = 0, cus = 0, per_cu = 0;
        (void)hipGetDevice(&dev);
        (void)hipDeviceGetAttribute(&cus, hipDeviceAttributeMultiprocessorCount, dev);
        if (hipFuncSetAttribute((const void*)megak, hipFuncAttributeMaxDynamicSharedMemorySize, LDS_BYTES) != hipSuccess) { fprintf(stderr, "kernel_launch: hipFuncSetAttribute failed\n"); grid = -1; return; }
        if (hipOccupancyMaxActiveBlocksPerMultiprocessor(&per_cu, (const void*)megak, NTHREADS, LDS_BYTES) != hipSuccess || per_cu < 1) { fprintf(stderr, "kernel_launch: occupancy query gave %d\n", per_cu); per_cu = 1; }
        (void)hipGetLastError();
        grid = cus * per_cu;
    }
    if (grid < 0) return;
    Params p{};
    p.x = (const float*)d_in[0]; p.mem = (const float*)d_in[1]; p.mem_norm_w = (const float*)d_in[2]; p.norm_w = (const float*)d_in[3];
    p.w_memkv = (const float*)d_in[4]; p.w_out = (const float*)d_in[5]; p.w_in_a = (const float*)d_in[6]; p.w_gate_up = (const float*)d_in[7];
    p.b_gate = (const float*)d_in[8]; p.gla_norm_w = (const float*)d_in[9]; p.w_in_b = (const float*)d_in[10]; p.final_norm_w = (const float*)d_in[11];
    p.out = (float*)d_out; p.ws = (unsigned char*)d_ws;
    (void)hipMemsetAsync((unsigned char*)d_ws + WS_BAR, 0, 16384, stream);
#if ONE_LAUNCH
    p.ph_lo = 0; p.ph_hi = NSTEPS;
    void* args[] = {&p};
    hipError_t e = hipLaunchCooperativeKernel((const void*)megak, dim3(grid), dim3(NTHREADS), args, LDS_BYTES, stream);
    if (e != hipSuccess) fprintf(stderr, "cooperative launch failed: %s (grid %d)\n", hipGetErrorString(e), grid);
#else
    for (int s = 0; s < NSTEPS; ++s) {
        p.ph_lo = s; p.ph_hi = s + 1;
        hipLaunchKernelGGL(megak, dim3(grid), dim3(NTHREADS), LDS_BYTES, stream, p);
    }
#endif
}
```
